# Optimizing an MI355X kernel written in HIP

```python
import math
import jax, jax.numpy as jnp
from jax import lax
import numpy as np

D_MODEL = 1024
BATCH = 2
SEQ = 8192
DEPTH = 1

HEAD_DIM = 64
ATTN_GROUPS = ((128, 1), (512, 4), (2048, 16))
N_ATTN_GROUPS = len(ATTN_GROUPS)
HEADS_PER_GROUP = 8
N_ATTN_HEADS = N_ATTN_GROUPS * HEADS_PER_GROUP
ATTN_OUT_WIDTH = HEADS_PER_GROUP * HEAD_DIM
QKV_WIDTH = 3 * N_ATTN_HEADS * HEAD_DIM
BLOCK = 128
REL_BUCKETS = 32
REL_MAX_DIST = 2048
SSM_WIDTH = D_MODEL // 2
SSM_GROUP = 16
SSM_GROUPS = SSM_WIDTH // SSM_GROUP
SSM_STATE = 64
IN_WIDTH = QKV_WIDTH + SSM_WIDTH + 2 * D_MODEL
N_EXPERTS = 32
TOP_K = 4
D_FF = D_MODEL
SWIGLU_LIMIT = 7.0
SWIGLU_ALPHA = 1.702
EPS = 1e-6

kernel_name = "hybrid_dilated_attn_s5_moe_block"


def rms_norm(x, g):
    xf = x.astype(jnp.float32)
    y = xf * lax.rsqrt(jnp.mean(xf * xf, axis=-1, keepdims=True) + EPS) * g.astype(jnp.float32)
    return y.astype(x.dtype)


def head_rms_norm(t, g):
    tf = t.astype(jnp.float32)
    return tf * lax.rsqrt(jnp.mean(tf * tf, axis=-1, keepdims=True) + EPS) * g.astype(jnp.float32)[:, None, :]


def rel_bucket_np(dist):
    max_exact = REL_BUCKETS // 2
    d = np.maximum(dist, 1).astype(np.float32)
    large = max_exact + (np.log(d / max_exact) / math.log(REL_MAX_DIST / max_exact)
                         * (REL_BUCKETS - max_exact)).astype(np.int32)
    large = np.minimum(large, REL_BUCKETS - 1)
    return np.where(dist < max_exact, dist, large).astype(np.int32)


def dilated_window_attention(q, k, v, bias_table, window, dilation):
    b, s, h, dh = q.shape
    span = window // dilation
    L = s // dilation
    blk = min(BLOCK, L)
    nblk = -(-L // blk)
    Lp = nblk * blk

    def to_blocks(t):
        t = t.reshape(b, L, dilation, h, dh).transpose(0, 2, 1, 3, 4).reshape(b * dilation, L, h, dh)
        t = jnp.pad(t, ((0, 0), (0, Lp - L), (0, 0), (0, 0)))
        return t.reshape(b * dilation, nblk, blk, h, dh)

    def with_prev(t):
        prev = jnp.pad(t, ((0, 0), (1, 0), (0, 0), (0, 0), (0, 0)))[:, :-1]
        return jnp.concatenate([prev, t], axis=2)

    qb = to_blocks(q)
    kc = with_prev(to_blocks(k))
    vc = with_prev(to_blocks(v))

    qi = np.arange(blk)[:, None]
    ki = np.arange(2 * blk)[None, :]
    steps = qi + blk - ki
    band = (steps >= 0) & (steps <= span)
    key_pos = np.arange(nblk)[:, None] * blk - blk + np.arange(2 * blk)[None, :]
    mask = band[None] & (key_pos >= 0)[:, None, :]
    bucket = rel_bucket_np(np.clip(steps, 0, None) * dilation)
    bias = jnp.transpose(bias_table[bucket], (2, 0, 1)).astype(jnp.float32)

    logits = jnp.einsum('nbqhd,nbkhd->nbhqk', qb, kc) + bias
    logits = jnp.where(mask[None, :, None], logits, -jnp.inf)
    m = jnp.max(logits, axis=-1, keepdims=True)
    p = jnp.exp(logits - m)
    den = jnp.sum(p, axis=-1)
    o = jnp.einsum('nbhqk,nbkhd->nbqhd', p, vc) / jnp.transpose(den, (0, 1, 3, 2))[..., None]
    lse = jnp.transpose(m[..., 0] + jnp.log(den), (0, 1, 3, 2))

    o = o.reshape(b, dilation, Lp, h, dh)[:, :, :L].transpose(0, 2, 1, 3, 4).reshape(b, s, h, dh)
    lse = lse.reshape(b, dilation, Lp, h)[:, :, :L].transpose(0, 2, 1, 3).reshape(b, s, h)
    return o, lse


def s5_ssm(u, a_re, a_im, log_dt, b_re, b_im, c_re, c_im, d_skip):
    bsz, s, _ = u.shape
    uf = u.astype(jnp.float32).reshape(bsz, s, SSM_GROUPS, SSM_GROUP)
    lam = lax.complex(a_re.astype(jnp.float32), a_im.astype(jnp.float32))
    dt = jnp.exp(log_dt.astype(jnp.float32))[:, None]
    a_bar = jnp.exp(lam * dt)
    b_mat = lax.complex(b_re.astype(jnp.float32), b_im.astype(jnp.float32))
    b_bar = ((a_bar - 1.0) / lam)[..., None] * b_mat
    bu = jnp.einsum('bsgc,gnc->bsgn', uf.astype(jnp.complex64), b_bar)
    a_full = jnp.broadcast_to(a_bar, bu.shape)

    def combine(earlier, later):
        a1, b1 = earlier
        a2, b2 = later
        return a2 * a1, a2 * b1 + b2

    _, states = lax.associative_scan(combine, (a_full, bu), axis=1)
    c_mat = lax.complex(c_re.astype(jnp.float32), c_im.astype(jnp.float32))
    y = jnp.einsum('bsgn,gcn->bsgc', states, c_mat).real
    y = y + d_skip.astype(jnp.float32).reshape(SSM_GROUPS, SSM_GROUP) * uf
    return y.reshape(bsz, s, SSM_WIDTH).astype(u.dtype)


def moe_ffn(h, w_router, b_router, w_gu, b_gu, w_down, b_down):
    b, s, d = h.shape
    t = h.reshape(-1, d)
    logits = (t @ w_router + b_router).astype(jnp.float32)
    top_v, top_i = lax.top_k(logits, TOP_K)
    gates = jax.nn.softmax(top_v, axis=-1)
    flat_e = top_i.reshape(-1)
    order = jnp.argsort(flat_e)
    e_sorted = flat_e[order]
    tok = order // TOP_K
    xs = t[tok]
    sizes = jnp.bincount(flat_e, length=N_EXPERTS).astype(jnp.int32)
    gu = lax.ragged_dot(xs, w_gu, sizes) + b_gu[e_sorted]
    x_glu = jnp.minimum(gu[:, :D_FF], SWIGLU_LIMIT)
    x_lin = jnp.clip(gu[:, D_FF:], -SWIGLU_LIMIT, SWIGLU_LIMIT)
    act = x_glu * jax.nn.sigmoid(SWIGLU_ALPHA * x_glu) * (x_lin + 1.0)
    out = lax.ragged_dot(act, w_down, sizes) + b_down[e_sorted]
    out = out * gates.reshape(-1)[order][:, None].astype(out.dtype)
    y = jnp.zeros_like(t).at[tok].add(out)
    return y.reshape(b, s, d)


def setup_inputs(seed: int = 0) -> dict:
    key = jax.random.key(seed)
    ks = jax.random.split(key, 26)
    f32 = jnp.float32
    L = DEPTH
    nrm = lambda k, shape, scale: jax.random.normal(k, shape, f32) * scale
    n_idx = jnp.arange(SSM_STATE, dtype=f32)
    return {
        "x": nrm(ks[0], (BATCH, SEQ, D_MODEL), 1.0),
        "g_mix": 1.0 + nrm(ks[1], (L, D_MODEL), 0.02),
        "w_in": nrm(ks[2], (L, D_MODEL, IN_WIDTH), D_MODEL ** -0.5),
        "q_gain": 1.0 + nrm(ks[3], (L, N_ATTN_GROUPS, HEAD_DIM), 0.02),
        "k_gain": 1.0 + nrm(ks[4], (L, N_ATTN_GROUPS, HEAD_DIM), 0.02),
        "rel_bias": nrm(ks[5], (REL_BUCKETS, N_ATTN_HEADS), 0.5),
        "ssm_a_re": -0.5 + nrm(ks[6], (L, SSM_GROUPS, SSM_STATE), 0.01),
        "ssm_a_im": math.pi * n_idx + nrm(ks[7], (L, SSM_GROUPS, SSM_STATE), 0.01),
        "ssm_log_dt": jax.random.uniform(ks[8], (L, SSM_GROUPS), f32, math.log(1e-3), math.log(1e-1)),
        "ssm_b_re": nrm(ks[9], (L, SSM_GROUPS, SSM_STATE, SSM_GROUP), (2 * SSM_GROUP) ** -0.5),
        "ssm_b_im": nrm(ks[10], (L, SSM_GROUPS, SSM_STATE, SSM_GROUP), (2 * SSM_GROUP) ** -0.5),
        "ssm_c_re": nrm(ks[11], (L, SSM_GROUPS, SSM_GROUP, SSM_STATE), (2 * SSM_STATE) ** -0.5),
        "ssm_c_im": nrm(ks[12], (L, SSM_GROUPS, SSM_GROUP, SSM_STATE), (2 * SSM_STATE) ** -0.5),
        "ssm_d": nrm(ks[13], (L, SSM_WIDTH), 1.0),
        "w_glu": nrm(ks[14], (L, SSM_WIDTH, SSM_WIDTH), SSM_WIDTH ** -0.5),
        "b_glu": nrm(ks[15], (L, SSM_WIDTH), 0.01),
        "w_attn_proj": nrm(ks[16], (L, ATTN_OUT_WIDTH, D_MODEL), ATTN_OUT_WIDTH ** -0.5),
        "w_ssm_proj": nrm(ks[17], (L, SSM_WIDTH, D_MODEL), SSM_WIDTH ** -0.5),
        "w_out": nrm(ks[18], (L, D_MODEL, D_MODEL), D_MODEL ** -0.5),
        "g_ffn": 1.0 + nrm(ks[19], (L, D_MODEL), 0.02),
        "w_router": nrm(ks[20], (L, D_MODEL, N_EXPERTS), D_MODEL ** -0.5),
        "b_router": nrm(ks[21], (L, N_EXPERTS), 0.01),
        "w_gate_up": nrm(ks[22], (L, N_EXPERTS, D_MODEL, 2 * D_FF), D_MODEL ** -0.5),
        "b_gate_up": nrm(ks[23], (L, N_EXPERTS, 2 * D_FF), 0.01),
        "w_down": nrm(ks[24], (L, N_EXPERTS, D_FF, D_MODEL), D_FF ** -0.5),
        "b_down": nrm(ks[25], (L, N_EXPERTS, D_MODEL), 0.01),
    }


def reference(x, g_mix, w_in, q_gain, k_gain, rel_bias, ssm_a_re, ssm_a_im, ssm_log_dt,
              ssm_b_re, ssm_b_im, ssm_c_re, ssm_c_im, ssm_d, w_glu, b_glu, w_attn_proj,
              w_ssm_proj, w_out, g_ffn, w_router, b_router, w_gate_up, b_gate_up, w_down, b_down):
    b, s, _ = x.shape
    for l in range(DEPTH):
        h = rms_norm(x, g_mix[l])
        proj = h @ w_in[l]
        qkv = proj[..., :QKV_WIDTH].reshape(b, s, 3, N_ATTN_GROUPS, HEADS_PER_GROUP, HEAD_DIM)
        u = proj[..., QKV_WIDTH:QKV_WIDTH + SSM_WIDTH]
        gate_a = proj[..., QKV_WIDTH + SSM_WIDTH:QKV_WIDTH + SSM_WIDTH + D_MODEL]
        gate_b = proj[..., QKV_WIDTH + SSM_WIDTH + D_MODEL:]

        q = head_rms_norm(qkv[:, :, 0], q_gain[l]) * (HEAD_DIM ** -0.5)
        k = head_rms_norm(qkv[:, :, 1], k_gain[l])
        v = qkv[:, :, 2].astype(jnp.float32)
        outs, lses = [], []
        for gi, (window, dilation) in enumerate(ATTN_GROUPS):
            table = rel_bias[:, gi * HEADS_PER_GROUP:(gi + 1) * HEADS_PER_GROUP]
            o_g, lse_g = dilated_window_attention(q[:, :, gi], k[:, :, gi], v[:, :, gi], table, window, dilation)
            outs.append(o_g)
            lses.append(lse_g)
        w_den = jax.nn.softmax(jnp.stack(lses, axis=0), axis=0)
        attn = jnp.einsum('gbsh,gbshd->bshd', w_den, jnp.stack(outs, axis=0))
        y_a = attn.reshape(b, s, ATTN_OUT_WIDTH).astype(x.dtype) @ w_attn_proj[l]

        y_s = s5_ssm(u, ssm_a_re[l], ssm_a_im[l], ssm_log_dt[l], ssm_b_re[l], ssm_b_im[l],
                     ssm_c_re[l], ssm_c_im[l], ssm_d[l])
        y_s = jax.nn.gelu(y_s)
        y_s = y_s * jax.nn.sigmoid(y_s @ w_glu[l] + b_glu[l])
        y_b = y_s @ w_ssm_proj[l]

        mixed = jax.nn.sigmoid(gate_a) * y_a + jax.nn.sigmoid(gate_b) * y_b
        x = x + mixed @ w_out[l]

        h2 = rms_norm(x, g_ffn[l])
        x = x + moe_ffn(h2, w_router[l], b_router[l], w_gate_up[l], b_gate_up[l], w_down[l], b_down[l])
    return x
```

```cpp
#include <hip/hip_runtime.h>
#include <cstdio>
#include <cstdint>

typedef unsigned short bf16;
#define DI __device__ __forceinline__

constexpr int DM = 1024, NB = 2, SEQ = 8192, T = NB * SEQ;
constexpr int HD = 64, NG = 3, HPG = 8, NH = 24, AOW = 512, QKVW = 4608;
constexpr int SSMW = 512, SGRP = 16, NSG = 32, NST = 64;
constexpr int INW = QKVW + SSMW + 2 * DM;
constexpr int NE = 32, TOPK = 4, DFF = 1024;
constexpr int LC = 32, NCHUNK = T / LC, A2K = LC * 16 + 128;
constexpr float EPS = 1e-6f, LOG2E = 1.4426950408889634f;
constexpr int LISTCAP = T;
constexpr int ACT_ROWS = 73728;

constexpr size_t MiB = 1u << 20;
constexpr size_t WS_CTL = 0;
constexpr size_t WS_BIAS2 = 1 * MiB;
constexpr size_t WS_H = 2 * MiB;
constexpr size_t WS_Q = 34 * MiB, WS_K = 82 * MiB, WS_V = 130 * MiB;
constexpr size_t WS_A2 = 178 * MiB;
constexpr size_t WS_GA = 198 * MiB, WS_GB = 230 * MiB;
constexpr size_t WS_OG = 262 * MiB;
constexpr size_t WS_LSE = 310 * MiB;
constexpr size_t WS_S1 = 312 * MiB;
constexpr size_t WS_ATT = 320 * MiB;
constexpr size_t WS_YS = 336 * MiB, WS_YS2 = 352 * MiB;
constexpr size_t WS_MIX = 368 * MiB;
constexpr size_t WS_H2 = 400 * MiB;
constexpr size_t WS_LIST = 432 * MiB;
constexpr size_t WS_GATE = 434 * MiB;
constexpr size_t WS_WIN = 436 * MiB, WS_WGLU = 450 * MiB, WS_WAP = 451 * MiB, WS_WSP = 452 * MiB, WS_WOUT = 453 * MiB;
constexpr size_t WS_WGU = 456 * MiB, WS_WD = 584 * MiB, WS_BT1 = 648 * MiB, WS_BT2 = 652 * MiB;
constexpr size_t WS_ACT = 672 * MiB;
constexpr size_t WS_YP = 816 * MiB;
constexpr size_t WS_END = 1024 * MiB;
constexpr size_t WS_PROJ = 456 * MiB;
constexpr size_t WS_TMPA = 672 * MiB, WS_TMPB = 736 * MiB;

DI float bf2f(bf16 v) { return __uint_as_float(((unsigned)v) << 16); }
DI bf16 f2bf(float f) { unsigned u = __float_as_uint(f); return (bf16)((u + 0x7fffu + ((u >> 16) & 1u)) >> 16); }
DI float wave_sum(float v) {
#pragma unroll
    for (int o = 1; o < 64; o <<= 1) v += __shfl_xor(v, o);
    return v;
}
DI float sigmoidf_(float x) { return 1.f / (1.f + __expf(-x)); }
DI float gelu_tanh(float x) { const float u = 0.7978845608028654f * (x + 0.044715f * x * x * x); return 0.5f * x * (1.f + tanhf(u)); }

__global__ void __launch_bounds__(256) n_rmsnorm(const float* x, const float* g, bf16* out) {
    const int row = blockIdx.x * 4 + (threadIdx.x >> 6), lane = threadIdx.x & 63;
    const float* xr = x + (size_t)row * DM;
    float v[16], s = 0.f;
#pragma unroll
    for (int j = 0; j < 16; ++j) { v[j] = xr[lane + 64 * j]; s += v[j] * v[j]; }
    const float r = rsqrtf(wave_sum(s) * (1.f / DM) + EPS);
#pragma unroll
    for (int j = 0; j < 16; ++j) out[(size_t)row * DM + lane + 64 * j] = f2bf(v[j] * r * g[lane + 64 * j]);
}

__global__ void __launch_bounds__(256) n_gemm(const bf16* A, int lda, const float* B, int ldb, float* C, int ldc, int K) {
    __shared__ float As[16][68], Bs[16][68];
    const int tid = threadIdx.x, tx = tid & 15, ty = tid >> 4, row0 = blockIdx.y * 64, col0 = blockIdx.x * 64;
    float acc[4][4] = {};
    for (int k0 = 0; k0 < K; k0 += 16) {
#pragma unroll
        for (int i = 0; i < 4; ++i) { const int idx = tid + i * 256, r = idx >> 4, kk = idx & 15; As[kk][r] = bf2f(A[(size_t)(row0 + r) * lda + k0 + kk]); }
#pragma unroll
        for (int i = 0; i < 4; ++i) { const int idx = tid + i * 256, kk = idx >> 6, c = idx & 63; Bs[kk][c] = B[(size_t)(k0 + kk) * ldb + col0 + c]; }
        __syncthreads();
#pragma unroll
        for (int kk = 0; kk < 16; ++kk) {
            float a[4], b[4];
#pragma unroll
            for (int i = 0; i < 4; ++i) { a[i] = As[kk][ty * 4 + i]; b[i] = Bs[kk][tx * 4 + i]; }
#pragma unroll
            for (int i = 0; i < 4; ++i)
#pragma unroll
                for (int j = 0; j < 4; ++j) acc[i][j] += a[i] * b[j];
        }
        __syncthreads();
    }
#pragma unroll
    for (int i = 0; i < 4; ++i)
#pragma unroll
        for (int j = 0; j < 4; ++j) C[(size_t)(row0 + ty * 4 + i) * ldc + col0 + tx * 4 + j] = acc[i][j];
}

__global__ void n_bias(const float* rel_bias, float* bias2) {
    const int i = blockIdx.x * blockDim.x + threadIdx.x;
    if (i >= 3 * 8 * 132) return;
    const int st = i % 132, h = (i / 132) % 8, g = i / (132 * 8);
    const int dil = (g == 0) ? 1 : (g == 1 ? 4 : 16);
    float val = 0.f;
    if (st <= 128) {
        const int dist = st * dil; int bucket;
        if (dist < 16) bucket = dist;
        else { const float d = (float)dist; int large = 16 + (int)(logf(d / 16.f) / 4.852030263919617f * 16.f); bucket = large < 31 ? large : 31; }
        val = rel_bias[bucket * NH + g * 8 + h] * LOG2E;
    }
    bias2[i] = val;
}

__global__ void __launch_bounds__(256) n_postproj(const float* proj, const float* q_gain, const float* k_gain,
                                                  bf16* Q, bf16* Kb, bf16* V, bf16* A2, bf16* GA, bf16* GB) {
    const int m = blockIdx.x, b = m / SEQ, s = m % SEQ, tid = threadIdx.x, w = tid >> 6, lane = tid & 63;
    const float* pr = proj + (size_t)m * INW;
    for (int hh = w; hh < 72; hh += 4) {
        const int three = hh / 24, gh = hh % 24, g = gh / 8, h = gh % 8;
        const float v = pr[hh * 64 + lane];
        const size_t o = ((((size_t)b * NG + g) * HPG + h) * SEQ + s) * HD + lane;
        if (three == 2) { V[o] = f2bf(v); }
        else {
            const float ss = wave_sum(v * v), r = rsqrtf(ss * (1.f / HD) + EPS);
            if (three == 0) Q[o] = f2bf(v * r * q_gain[g * HD + lane] * (0.125f * LOG2E));
            else Kb[o] = f2bf(v * r * k_gain[g * HD + lane]);
        }
    }
    for (int c = tid; c < SSMW; c += 256) {
        const int g = c >> 4, cc = c & 15;
        A2[((size_t)g * NCHUNK + (m >> 5)) * A2K + (m & 31) * 16 + cc] = f2bf(pr[QKVW + c]);
    }
    for (int c = tid; c < DM; c += 256) {
        GA[(size_t)m * DM + c] = f2bf(sigmoidf_(pr[QKVW + SSMW + c]));
        GB[(size_t)m * DM + c] = f2bf(sigmoidf_(pr[QKVW + SSMW + DM + c]));
    }
}

__global__ void __launch_bounds__(256) n_attn(const bf16* Q, const bf16* Kb, const bf16* V, const float* bias2, bf16* OG, float* LSE) {
    const int item = blockIdx.x * 4 + (threadIdx.x >> 6), lane = threadIdx.x & 63;
    const int s = item % SEQ, h = (item / SEQ) % HPG, g = (item / (SEQ * HPG)) % NG, b = item / (SEQ * HPG * NG);
    const int dil = (g == 0) ? 1 : (g == 1 ? 4 : 16);
    const size_t base = (((size_t)b * NG + g) * HPG + h) * SEQ * HD;
    const float q = bf2f(Q[base + (size_t)s * HD + lane]);
    const float* bt = bias2 + (g * 8 + h) * 132;
    float mx = -INFINITY, den = 0.f, acc = 0.f;
    for (int st = 0; st <= 128; ++st) {
        const int tk = s - st * dil; if (tk < 0) break;
        const float kv = bf2f(Kb[base + (size_t)tk * HD + lane]);
        const float dot = wave_sum(q * kv) + bt[st];
        const float mn = fmaxf(mx, dot), sc = exp2f(mx - mn), p = exp2f(dot - mn);
        acc = acc * sc + p * bf2f(V[base + (size_t)tk * HD + lane]); den = den * sc + p; mx = mn;
    }
    const int m = b * SEQ + s;
    OG[((size_t)g * T + m) * AOW + h * HD + lane] = f2bf(acc / den);
    if (lane == 0) LSE[((size_t)g * T + m) * 8 + h] = mx + log2f(den);
}

__global__ void __launch_bounds__(256) n_combine(const bf16* OG, const float* LSE, bf16* ATT) {
    const size_t i = (size_t)blockIdx.x * 256 + threadIdx.x;
    const int m = (int)(i / AOW), c = (int)(i % AOW), h = c / HD;
    float l[3], mx = -INFINITY;
#pragma unroll
    for (int g = 0; g < 3; ++g) { l[g] = LSE[((size_t)g * T + m) * 8 + h]; mx = fmaxf(mx, l[g]); }
    float w[3], sw = 0.f;
#pragma unroll
    for (int g = 0; g < 3; ++g) { w[g] = exp2f(l[g] - mx); sw += w[g]; }
    float o = 0.f;
#pragma unroll
    for (int g = 0; g < 3; ++g) o += w[g] * bf2f(OG[((size_t)g * T + m) * AOW + c]);
    ATT[i] = f2bf(o / sw);
}

__global__ void __launch_bounds__(64) n_ssm(const bf16* A2, const float* a_re, const float* a_im, const float* log_dt,
                                            const float* b_re, const float* b_im, const float* c_re, const float* c_im,
                                            const float* dsk, bf16* YS) {
    const int b = blockIdx.x / NSG, g = blockIdx.x % NSG, n = threadIdx.x;
    const float dt = expf(log_dt[g]);
    const float lr = a_re[g * NST + n], li = a_im[g * NST + n];
    const float er = expf(lr * dt); float sn, cs; sn = sinf(li * dt); cs = cosf(li * dt);
    const float ar = er * cs, ai = er * sn;
    const float nr = ar - 1.f, ni = ai, den = lr * lr + li * li;
    const float fr = (nr * lr + ni * li) / den, fi = (ni * lr - nr * li) / den;
    float bbr[16], bbi[16], cr[16], ci[16], dd[16];
#pragma unroll
    for (int c = 0; c < 16; ++c) {
        const float br = b_re[(g * NST + n) * 16 + c], bi = b_im[(g * NST + n) * 16 + c];
        bbr[c] = fr * br - fi * bi; bbi[c] = fr * bi + fi * br;
        cr[c] = c_re[(g * 16 + c) * NST + n]; ci[c] = c_im[(g * 16 + c) * NST + n];
        dd[c] = dsk[g * 16 + c];
    }
    float xr = 0.f, xi = 0.f;
    for (int s = 0; s < SEQ; ++s) {
        const int m = b * SEQ + s;
        const bf16* up = A2 + ((size_t)g * NCHUNK + (m >> 5)) * A2K + (m & 31) * 16;
        float u[16];
#pragma unroll
        for (int c = 0; c < 16; ++c) u[c] = bf2f(up[c]);
        float br = 0.f, bi = 0.f;
#pragma unroll
        for (int c = 0; c < 16; ++c) { br += bbr[c] * u[c]; bi += bbi[c] * u[c]; }
        const float nxr = ar * xr - ai * xi + br, nxi = ar * xi + ai * xr + bi; xr = nxr; xi = nxi;
        float mine = 0.f;
#pragma unroll
        for (int c = 0; c < 16; ++c) { const float y = wave_sum(cr[c] * xr - ci[c] * xi) + dd[c] * u[c]; if (n == c) mine = y; }
        if (n < 16) YS[(size_t)m * SSMW + g * 16 + n] = f2bf(gelu_tanh(mine));
    }
}

__global__ void __launch_bounds__(256) n_glu(const bf16* YS, const float* Z, const float* b_glu, bf16* YS2) {
    const size_t i = (size_t)blockIdx.x * 256 + threadIdx.x; const int c = (int)(i % SSMW);
    YS2[i] = f2bf(bf2f(YS[i]) * sigmoidf_(Z[i] + b_glu[c]));
}
__global__ void __launch_bounds__(256) n_mix(const bf16* GA, const bf16* GB, const float* YA, const float* YB, bf16* MIX) {
    const size_t i = (size_t)blockIdx.x * 256 + threadIdx.x;
    MIX[i] = f2bf(bf2f(GA[i]) * YA[i] + bf2f(GB[i]) * YB[i]);
}
__global__ void __launch_bounds__(256) n_resid(const float* x, const float* Tm, float* out) {
    const size_t i = (size_t)blockIdx.x * 256 + threadIdx.x; out[i] = x[i] + Tm[i];
}

__global__ void __launch_bounds__(256) n_route(const float* X1, const float* g_ffn, const float* w_router, const float* b_router,
                                               bf16* H2, int* CNT, int* LIST, float* GATE) {
    const int t = blockIdx.x * 4 + (threadIdx.x >> 6), lane = threadIdx.x & 63;
    const float* xr = X1 + (size_t)t * DM;
    float v[16], s = 0.f;
#pragma unroll
    for (int j = 0; j < 16; ++j) { v[j] = xr[lane + 64 * j]; s += v[j] * v[j]; }
    const float r = rsqrtf(wave_sum(s) * (1.f / DM) + EPS);
#pragma unroll
    for (int j = 0; j < 16; ++j) { v[j] = v[j] * r * g_ffn[lane + 64 * j]; H2[(size_t)t * DM + lane + 64 * j] = f2bf(v[j]); }
    float mine = -INFINITY;
    for (int e = 0; e < NE; ++e) {
        float p = 0.f;
#pragma unroll
        for (int j = 0; j < 16; ++j) p += v[j] * w_router[(size_t)(lane + 64 * j) * NE + e];
        p = wave_sum(p) + b_router[e];
        if (lane == e) mine = p;
    }
    float tv[4]; int ti[4];
#pragma unroll
    for (int k = 0; k < 4; ++k) {
        float bv = mine; int bi = lane;
#pragma unroll
        for (int o = 1; o < 64; o <<= 1) {
            const float ov = __shfl_xor(bv, o); const int oi = __shfl_xor(bi, o);
            if (ov > bv || (ov == bv && oi < bi)) { bv = ov; bi = oi; }
        }
        tv[k] = bv; ti[k] = bi; if (lane == bi) mine = -INFINITY;
    }
    float ex[4], se = 0.f;
#pragma unroll
    for (int k = 0; k < 4; ++k) { ex[k] = __expf(tv[k] - tv[0]); se += ex[k]; }
    if (lane == 0) {
#pragma unroll
        for (int k = 0; k < 4; ++k) {
            const int pos = atomicAdd(&CNT[ti[k]], 1);
            LIST[ti[k] * LISTCAP + pos] = t * 4 + k; GATE[t * 4 + k] = ex[k] / se;
        }
    }
}

DI int expert_row_base(const int* CNT, int e) { int rb = 0; for (int i = 0; i < e; ++i) rb += (CNT[i] + 255) & ~255; return rb; }

__global__ void __launch_bounds__(256) n_moe_gu(const bf16* H2, const float* Wgu, const float* bgu, const int* CNT, const int* LIST, bf16* ACT) {
    const int e = blockIdx.z, cnt = CNT[e], row0 = blockIdx.y * 64; if (row0 >= cnt) return;
    __shared__ float As[16][68], Bg[16][68], Bl[16][68]; __shared__ int tok[64];
    const int tid = threadIdx.x, tx = tid & 15, ty = tid >> 4, col0 = blockIdx.x * 64;
    if (tid < 64) { const int r = row0 + tid; tok[tid] = (r < cnt) ? (LIST[e * LISTCAP + r] >> 2) : 0; }
    __syncthreads();
    const float* B = Wgu + (size_t)e * DM * 2 * DFF;
    float ag[4][4] = {}, al[4][4] = {};
    for (int k0 = 0; k0 < DM; k0 += 16) {
#pragma unroll
        for (int i = 0; i < 4; ++i) { const int idx = tid + i * 256, r = idx >> 4, kk = idx & 15; As[kk][r] = bf2f(H2[(size_t)tok[r] * DM + k0 + kk]); }
#pragma unroll
        for (int i = 0; i < 4; ++i) { const int idx = tid + i * 256, kk = idx >> 6, c = idx & 63;
            Bg[kk][c] = B[(size_t)(k0 + kk) * (2 * DFF) + col0 + c]; Bl[kk][c] = B[(size_t)(k0 + kk) * (2 * DFF) + DFF + col0 + c]; }
        __syncthreads();
#pragma unroll
        for (int kk = 0; kk < 16; ++kk) {
            float a[4], bg[4], bl[4];
#pragma unroll
            for (int i = 0; i < 4; ++i) { a[i] = As[kk][ty * 4 + i]; bg[i] = Bg[kk][tx * 4 + i]; bl[i] = Bl[kk][tx * 4 + i]; }
#pragma unroll
            for (int i = 0; i < 4; ++i)
#pragma unroll
                for (int j = 0; j < 4; ++j) { ag[i][j] += a[i] * bg[j]; al[i][j] += a[i] * bl[j]; }
        }
        __syncthreads();
    }
    const int rb = expert_row_base(CNT, e);
#pragma unroll
    for (int i = 0; i < 4; ++i) { const int r = row0 + ty * 4 + i; if (r >= cnt) continue;
#pragma unroll
        for (int j = 0; j < 4; ++j) { const int c = col0 + tx * 4 + j;
            const float xg = fminf(ag[i][j] + bgu[e * 2 * DFF + c], 7.f);
            const float xl = fminf(fmaxf(al[i][j] + bgu[e * 2 * DFF + DFF + c], -7.f), 7.f);
            ACT[(size_t)(rb + r) * DFF + c] = f2bf(xg * sigmoidf_(1.702f * xg) * (xl + 1.f)); } }
}

__global__ void __launch_bounds__(256) n_moe_dn(const bf16* ACT, const float* Wd, const float* bd, const int* CNT, const int* LIST, const float* GATE, bf16* YP) {
    const int e = blockIdx.z, cnt = CNT[e], row0 = blockIdx.y * 64; if (row0 >= cnt) return;
    __shared__ float As[16][68], Bs[16][68];
    const int tid = threadIdx.x, tx = tid & 15, ty = tid >> 4, col0 = blockIdx.x * 64;
    const int rb = expert_row_base(CNT, e);
    const float* B = Wd + (size_t)e * DFF * DM;
    float acc[4][4] = {};
    for (int k0 = 0; k0 < DFF; k0 += 16) {
#pragma unroll
        for (int i = 0; i < 4; ++i) { const int idx = tid + i * 256, r = idx >> 4, kk = idx & 15; As[kk][r] = bf2f(ACT[(size_t)(rb + row0 + r) * DFF + k0 + kk]); }
#pragma unroll
        for (int i = 0; i < 4; ++i) { const int idx = tid + i * 256, kk = idx >> 6, c = idx & 63; Bs[kk][c] = B[(size_t)(k0 + kk) * DM + col0 + c]; }
        __syncthreads();
#pragma unroll
        for (int kk = 0; kk < 16; ++kk) {
            float a[4], b[4];
#pragma unroll
            for (int i = 0; i < 4; ++i) { a[i] = As[kk][ty * 4 + i]; b[i] = Bs[kk][tx * 4 + i]; }
#pragma unroll
            for (int i = 0; i < 4; ++i)
#pragma unroll
                for (int j = 0; j < 4; ++j) acc[i][j] += a[i] * b[j];
        }
        __syncthreads();
    }
#pragma unroll
    for (int i = 0; i < 4; ++i) { const int r = row0 + ty * 4 + i; if (r >= cnt) continue;
        const int pair = LIST[e * LISTCAP + r]; const float gt = GATE[pair];
#pragma unroll
        for (int j = 0; j < 4; ++j) { const int c = col0 + tx * 4 + j; YP[(size_t)pair * DM + c] = f2bf((acc[i][j] + bd[e * DM + c]) * gt); } }
}

__global__ void __launch_bounds__(256) n_final(const bf16* YP, float* out) {
    const size_t i = (size_t)blockIdx.x * 256 + threadIdx.x; const size_t t = i / DM, c = i % DM;
    float s = out[i];
#pragma unroll
    for (int k = 0; k < 4; ++k) s += bf2f(YP[(t * 4 + k) * DM + c]);
    out[i] = s;
}

extern "C" void kernel_launch(void* const* d_in, const int* in_sizes, int n_in, void* d_out, int out_size, void* d_ws, size_t ws_size, hipStream_t stream) {
    if (n_in != 26 || ws_size < WS_END) { fprintf(stderr, "kernel_launch: unexpected n_in %d / ws_size %zu\n", n_in, ws_size); return; }
    const float* x = (const float*)d_in[0];
    const float* g_mix = (const float*)d_in[1];
    const float* w_in = (const float*)d_in[2];
    const float* q_gain = (const float*)d_in[3];
    const float* k_gain = (const float*)d_in[4];
    const float* rel_bias = (const float*)d_in[5];
    const float* a_re = (const float*)d_in[6];
    const float* a_im = (const float*)d_in[7];
    const float* log_dt = (const float*)d_in[8];
    const float* b_re = (const float*)d_in[9];
    const float* b_im = (const float*)d_in[10];
    const float* c_re = (const float*)d_in[11];
    const float* c_im = (const float*)d_in[12];
    const float* ssm_d = (const float*)d_in[13];
    const float* w_glu = (const float*)d_in[14];
    const float* b_glu = (const float*)d_in[15];
    const float* w_ap = (const float*)d_in[16];
    const float* w_sp = (const float*)d_in[17];
    const float* w_out = (const float*)d_in[18];
    const float* g_ffn = (const float*)d_in[19];
    const float* w_router = (const float*)d_in[20];
    const float* b_router = (const float*)d_in[21];
    const float* w_gu = (const float*)d_in[22];
    const float* b_gu = (const float*)d_in[23];
    const float* w_dn = (const float*)d_in[24];
    const float* b_dn = (const float*)d_in[25];
    float* out = (float*)d_out;
    char* ws = (char*)d_ws;
    int* CNT = (int*)(ws + WS_CTL);
    float* BIAS2 = (float*)(ws + WS_BIAS2);
    bf16* H = (bf16*)(ws + WS_H);
    bf16 *Q = (bf16*)(ws + WS_Q), *Kb = (bf16*)(ws + WS_K), *V = (bf16*)(ws + WS_V), *A2 = (bf16*)(ws + WS_A2);
    bf16 *GA = (bf16*)(ws + WS_GA), *GB = (bf16*)(ws + WS_GB), *OG = (bf16*)(ws + WS_OG), *ATT = (bf16*)(ws + WS_ATT);
    float* LSE = (float*)(ws + WS_LSE);
    bf16 *YS = (bf16*)(ws + WS_YS), *YS2 = (bf16*)(ws + WS_YS2), *MIX = (bf16*)(ws + WS_MIX), *H2 = (bf16*)(ws + WS_H2);
    int* LIST = (int*)(ws + WS_LIST); float* GATE = (float*)(ws + WS_GATE);
    bf16 *ACT = (bf16*)(ws + WS_ACT), *YP = (bf16*)(ws + WS_YP);
    float *PROJ = (float*)(ws + WS_PROJ), *TMPA = (float*)(ws + WS_TMPA), *TMPB = (float*)(ws + WS_TMPB);

    hipMemsetAsync(ws + WS_CTL, 0, 1 * MiB, stream);
    n_bias<<<(3 * 8 * 132 + 255) / 256, 256, 0, stream>>>(rel_bias, BIAS2);
    n_rmsnorm<<<T / 4, 256, 0, stream>>>(x, g_mix, H);
    n_gemm<<<dim3(INW / 64, T / 64), 256, 0, stream>>>(H, DM, w_in, INW, PROJ, INW, DM);
    n_postproj<<<T, 256, 0, stream>>>(PROJ, q_gain, k_gain, Q, Kb, V, A2, GA, GB);
    n_attn<<<T * NH / 4, 256, 0, stream>>>(Q, Kb, V, BIAS2, OG, LSE);
    n_combine<<<T * AOW / 256, 256, 0, stream>>>(OG, LSE, ATT);
    n_ssm<<<NB * NSG, 64, 0, stream>>>(A2, a_re, a_im, log_dt, b_re, b_im, c_re, c_im, ssm_d, YS);
    n_gemm<<<dim3(SSMW / 64, T / 64), 256, 0, stream>>>(YS, SSMW, w_glu, SSMW, TMPA, SSMW, SSMW);
    n_glu<<<T * SSMW / 256, 256, 0, stream>>>(YS, TMPA, b_glu, YS2);
    n_gemm<<<dim3(DM / 64, T / 64), 256, 0, stream>>>(ATT, AOW, w_ap, DM, TMPA, DM, AOW);
    n_gemm<<<dim3(DM / 64, T / 64), 256, 0, stream>>>(YS2, SSMW, w_sp, DM, TMPB, DM, SSMW);
    n_mix<<<T * DM / 256, 256, 0, stream>>>(GA, GB, TMPA, TMPB, MIX);
    n_gemm<<<dim3(DM / 64, T / 64), 256, 0, stream>>>(MIX, DM, w_out, DM, TMPA, DM, DM);
    n_resid<<<T * DM / 256, 256, 0, stream>>>(x, TMPA, out);
    n_route<<<T / 4, 256, 0, stream>>>(out, g_ffn, w_router, b_router, H2, CNT, LIST, GATE);
    n_moe_gu<<<dim3(DFF / 64, T / 64, NE), 256, 0, stream>>>(H2, w_gu, b_gu, CNT, LIST, ACT);
    n_moe_dn<<<dim3(DM / 64, T / 64, NE), 256, 0, stream>>>(ACT, w_dn, b_dn, CNT, LIST, GATE, YP);
    n_final<<<T * DM / 256, 256, 0, stream>>>(YP, out);
}
```

```cpp
#include <hip/hip_runtime.h>
#include <cstdio>
#include <cstdint>

typedef unsigned short bf16;
#define DI __device__ __forceinline__

constexpr int DM = 1024, NB = 2, SEQ = 8192, T = NB * SEQ;
constexpr int HD = 64, NG = 3, HPG = 8, NH = 24, AOW = 512, QKVW = 4608;
constexpr int SSMW = 512, SGRP = 16, NSG = 32, NST = 64;
constexpr int INW = QKVW + SSMW + 2 * DM;
constexpr int NE = 32, TOPK = 4, DFF = 1024;
constexpr int LC = 32, NCHUNK = T / LC, A2K = LC * 16 + 128;
constexpr float EPS = 1e-6f, LOG2E = 1.4426950408889634f;
constexpr int LISTCAP = T;
constexpr int ACT_ROWS = 73728;

constexpr size_t MiB = 1u << 20;
constexpr size_t WS_CTL = 0;
constexpr size_t WS_BIAS2 = 1 * MiB;
constexpr size_t WS_H = 2 * MiB;
constexpr size_t WS_Q = 34 * MiB, WS_K = 82 * MiB, WS_V = 130 * MiB;
constexpr size_t WS_A2 = 178 * MiB;
constexpr size_t WS_GA = 198 * MiB, WS_GB = 230 * MiB;
constexpr size_t WS_OG = 262 * MiB;
constexpr size_t WS_LSE = 310 * MiB;
constexpr size_t WS_S1 = 312 * MiB;
constexpr size_t WS_ATT = 320 * MiB;
constexpr size_t WS_YS = 336 * MiB, WS_YS2 = 352 * MiB;
constexpr size_t WS_MIX = 368 * MiB;
constexpr size_t WS_H2 = 400 * MiB;
constexpr size_t WS_LIST = 432 * MiB;
constexpr size_t WS_GATE = 434 * MiB;
constexpr size_t WS_WIN = 436 * MiB, WS_WGLU = 450 * MiB, WS_WAP = 451 * MiB, WS_WSP = 452 * MiB, WS_WOUT = 453 * MiB;
constexpr size_t WS_WGU = 456 * MiB, WS_WD = 584 * MiB, WS_BT1 = 648 * MiB, WS_BT2 = 652 * MiB;
constexpr size_t WS_ACT = 672 * MiB;
constexpr size_t WS_YP = 816 * MiB;
constexpr size_t WS_END = 1024 * MiB;
constexpr size_t WS_PROJ = 456 * MiB;
constexpr size_t WS_TMPA = 672 * MiB, WS_TMPB = 736 * MiB;

DI float bf2f(bf16 v) { return __uint_as_float(((unsigned)v) << 16); }
DI bf16 f2bf(float f) { unsigned u = __float_as_uint(f); return (bf16)((u + 0x7fffu + ((u >> 16) & 1u)) >> 16); }
DI float wave_sum(float v) {
#pragma unroll
    for (int o = 1; o < 64; o <<= 1) v += __shfl_xor(v, o);
    return v;
}
DI float sigmoidf_(float x) { return 1.f / (1.f + __expf(-x)); }
DI float gelu_tanh(float x) { const float u = 0.7978845608028654f * (x + 0.044715f * x * x * x); return 0.5f * x * (1.f + tanhf(u)); }


#define LAS __attribute__((address_space(3)))
#define GAS __attribute__((address_space(1)))
typedef short bf16x8 __attribute__((ext_vector_type(8)));
typedef float f32x4 __attribute__((ext_vector_type(4)));
typedef float f32x2 __attribute__((ext_vector_type(2)));
typedef unsigned u32x4 __attribute__((ext_vector_type(4)));
typedef unsigned u32x2 __attribute__((ext_vector_type(2)));
typedef GAS unsigned gu32;
#define RLX_AGENT __ATOMIC_RELAXED, __HIP_MEMORY_SCOPE_AGENT
#define LDS_WAIT() asm volatile("s_waitcnt lgkmcnt(0)" ::: "memory")
#define VM_WAIT() asm volatile("s_waitcnt vmcnt(0)" ::: "memory")
constexpr int NWAVES = 8, NTHREADS = 512;
constexpr int RING_OFF = 0, RING_BYTES = 131072, LDSCTL_OFF = RING_BYTES, MISC_OFF = LDSCTL_OFF + 320, LDS_BYTES = 147456;
constexpr int CW_BAR = 4096;

DI unsigned cvt_pk_bf16(float lo, float hi) { unsigned r; asm volatile("v_cvt_pk_bf16_f32 %0, %1, %2" : "=v"(r) : "v"(lo), "v"(hi)); return r; }
DI unsigned pk2(float lo, float hi) { return (unsigned)f2bf(lo) | ((unsigned)f2bf(hi) << 16); }

#define XB_TMO      128
#define XB_XCNT(j)  (256  + 64 * (j))
#define XB_XSUB(j)  (1280 + 64 * (j))
#define XB_XGEN(j)  (2304 + 64 * (j))
#define XB_TOP      3328
#define XB_TOPGEN   3392
#define XCD_BAR_WORDS 3456
#define XB_SPIN_CAP (1u << 18)
DI unsigned xb_ld(unsigned* p)              { return __hip_atomic_load(p, __ATOMIC_RELAXED, __HIP_MEMORY_SCOPE_AGENT); }
DI unsigned xb_add(unsigned* p, unsigned v) { return __hip_atomic_fetch_add(p, v, __ATOMIC_RELAXED, __HIP_MEMORY_SCOPE_AGENT); }
DI unsigned xb_xcc_id() { return (unsigned)__builtin_amdgcn_s_getreg((3 << 11) | 20) & 0xFu; }
#define XB_SPIN(cond, bar) do { unsigned _sp = 0; while (cond) { __builtin_amdgcn_s_sleep(1); \
    if ((++_sp & 255u) == 0u) { if (xb_ld(&(bar)[XB_TMO])) break; if (_sp > XB_SPIN_CAP) { atomicAdd(&(bar)[XB_TMO], 1u); break; } } } } while (0)
struct XcdBarrier { unsigned* bar; unsigned x; volatile LAS unsigned* st; };
DI XcdBarrier xcd_barrier_post(unsigned* bar, volatile LAS unsigned* st) {
    XcdBarrier b; b.bar = bar; b.x = xb_xcc_id(); b.st = st;
    if (threadIdx.x == 0) (void)xb_add(&bar[XB_XCNT(b.x)], 1u);
    return b;
}
DI void xcd_barrier_complete(unsigned* bar, unsigned x, unsigned& nloc, unsigned& nx) {
    const unsigned G = gridDim.x * gridDim.y * gridDim.z;
    unsigned sum, cnt, mine, sp = 0u;
    for (;;) {
        sum = 0u; cnt = 0u; mine = 0u;
#pragma unroll
        for (unsigned j = 0; j < 16; ++j) { const unsigned c = xb_ld(&bar[XB_XCNT(j)]); sum += c; cnt += (c > 0u) ? 1u : 0u; mine = (j == x) ? c : mine; }
        if (sum == G) break;
        __builtin_amdgcn_s_sleep(1);
        if ((++sp & 255u) == 0u) { if (xb_ld(&bar[XB_TMO])) break; if (sp > XB_SPIN_CAP) { atomicAdd(&bar[XB_TMO], 1u); break; } }
    }
    nloc = mine > 0u ? mine : 1u; nx = cnt > 0u ? cnt : 1u;
}
DI void xcd_barrier(const XcdBarrier& b) {
    asm volatile("s_waitcnt vmcnt(0)" ::: "memory");
    __syncthreads();
    if (threadIdx.x == 0) {
        unsigned* bar = b.bar;
        __builtin_amdgcn_s_waitcnt(0);
        unsigned nloc = b.st[0], nx = b.st[1];
        if (nloc == 0u) { xcd_barrier_complete(bar, b.x, nloc, nx); b.st[0] = nloc; b.st[1] = nx; }
        const unsigned old = xb_add(&bar[XB_XSUB(b.x)], 1u);
        const unsigned gen = old / nloc;
        if (old + 1u == (gen + 1u) * nloc) {
            __builtin_amdgcn_fence(__ATOMIC_RELEASE, "agent");
            asm volatile("s_waitcnt vmcnt(0)" ::: "memory");
            const unsigned og = xb_add(&bar[XB_TOP], 1u);
            const unsigned tg = og / nx;
            if (og + 1u == (tg + 1u) * nx) xb_add(&bar[XB_TOPGEN], 1u);
            else XB_SPIN(xb_ld(&bar[XB_TOPGEN]) == tg, bar);
            __builtin_amdgcn_fence(__ATOMIC_ACQUIRE, "agent");
            xb_add(&bar[XB_XGEN(b.x)], 1u);
            asm volatile("s_waitcnt vmcnt(0)" ::: "memory");
        } else {
            XB_SPIN(xb_ld(&bar[XB_XGEN(b.x)]) == gen, bar);
            __builtin_amdgcn_fence(__ATOMIC_ACQUIRE, "agent");
            asm volatile("s_waitcnt vmcnt(0)" ::: "memory");
        }
    }
    __syncthreads();
}

namespace pg8 {
constexpr int BM = 256, BK = 64, HALF = 128, HTB = HALF * BK * 2, STAGE_BYTES = 8 * HTB, NXCD = 8, WGM = 8;
__host__ __device__ __forceinline__ int lds_byte(int r, int c) { const int st = (r >> 4) * 2 + (c >> 5), rr = r & 15, cc = c & 31, ob = rr * 64 + cc * 2; return st * 1024 + (ob ^ (((ob >> 9) & 1) << 5)); }
__host__ __device__ __forceinline__ void stage_rc(int b, int& R, int& C) { const int st = b / 1024, sb = b % 1024, swz = sb ^ (((sb >> 9) & 1) << 5); R = (st >> 1) * 16 + swz / 64; C = (st & 1) * 32 + (swz % 64) / 2; }
__host__ __device__ __forceinline__ int perm32(int rho) { const int n = rho >> 4, i = rho & 15; return 8 * (i >> 2) + 4 * n + (i & 3); }

struct Unit { const char* A; const char* B; int pm, pn, e, aux; };

DI void tile_of(int L, int nM, int nN, int& pm, int& pn) {
    const int nwg = nM * nN; int wgid = L;
    { const int q = nwg / NXCD, r = nwg % NXCD, xcd = wgid % NXCD, off = wgid / NXCD; wgid = (xcd < r ? xcd * (q + 1) : r * (q + 1) + (xcd - r) * q) + off; }
    const int nig = WGM * nN, gid = wgid / nig, fm = gid * WGM, gsz = (nM - fm) < WGM ? (nM - fm) : WGM;
    pm = fm + ((wgid % nig) % gsz); pn = (wgid % nig) / gsz;
}
struct PlainSched {
    const char* A; const char* B; int K, nM, nN, G, c;
    DI bool next(int i, Unit& u) const {
        const long L = (long)i * G + c; if (L >= (long)nM * nN) return false;
        int pm, pn; tile_of((int)L, nM, nN, pm, pn);
        u.pm = pm; u.pn = pn; u.e = 0; u.aux = 0; u.A = A + (size_t)pm * BM * K * 2; u.B = B + (size_t)pn * BM * K * 2; return true;
    }
    DI void aoff(const Unit&, const int (&R)[2], const int (&C)[2], unsigned (&v)[2][2]) const {
#pragma unroll
        for (int h = 0; h < 2; ++h)
#pragma unroll
            for (int i = 0; i < 2; ++i) v[h][i] = (unsigned)((h * HALF + R[i]) * K + C[i]) * 2u;
    }
};

template <class Epi, class Sched>
__device__ __forceinline__ void gemm_phase(LAS unsigned char* lds, const int K, const Sched& S, const Epi& E) {
    const int tid = threadIdx.x, wid = __builtin_amdgcn_readfirstlane(tid >> 6), lane = tid & 63, wr = wid >> 2, wc = wid & 3, fr = lane & 15, fq = lane >> 4;
    const int nt = K / BK;
    int Rr[2], Cc[2]; unsigned vB[2][2];
#pragma unroll
    for (int i = 0; i < 2; ++i) { int R, C; stage_rc(tid * 16 + i * 8192, R, C); Rr[i] = R; Cc[i] = C; const int Rb = (R & ~31) + perm32(R & 31);
        vB[0][i] = (unsigned)(Rb * K + C) * 2u; vB[1][i] = (unsigned)((HALF + Rb) * K + C) * 2u; }
    const size_t kstep = (size_t)(BK * 2);
    const unsigned ldsw = (unsigned)wid * 1024u;
    const int aoff = lds_byte(wr * 64 + fr, fq * 8), boff = lds_byte(wc * 32 + fr, fq * 8);
#define PG8_SA(b, h) (((b) * 2 + (h)) * HTB)
#define PG8_SB(b, h) ((4 + (b) * 2 + (h)) * HTB)
#define PG8_STAGE(bufoff, gbase, voff) do { _Pragma("unroll") for (int _i = 0; _i < 2; ++_i) \
        __builtin_amdgcn_global_load_lds((const unsigned*)((const char*)(gbase) + (voff)[_i]), (LAS unsigned*)(lds + (bufoff) + ldsw + _i * 8192), 16, 0, 0); } while (0)
#define PG8_LDA(dst, b, h) do { _Pragma("unroll") for (int m = 0; m < 4; ++m) _Pragma("unroll") for (int k = 0; k < 2; ++k) dst[m][k] = *(const LAS bf16x8*)(lds + PG8_SA(b, h) + aoff + m * 2048 + k * 1024); } while (0)
#define PG8_LDB(dst, b, h) do { _Pragma("unroll") for (int n = 0; n < 2; ++n) _Pragma("unroll") for (int k = 0; k < 2; ++k) dst[n][k] = *(const LAS bf16x8*)(lds + PG8_SB(b, h) + boff + n * 2048 + k * 1024); } while (0)
#define PG8_MMA(ai, bj, At, Bt) do { __builtin_amdgcn_s_setprio(1); _Pragma("unroll") for (int m = 0; m < 4; ++m) _Pragma("unroll") for (int n = 0; n < 2; ++n) _Pragma("unroll") for (int k = 0; k < 2; ++k) \
        acc[ai][bj][m][n] = __builtin_amdgcn_mfma_f32_16x16x32_bf16(Bt[n][k], At[m][k], acc[ai][bj][m][n], 0, 0, 0); __builtin_amdgcn_s_setprio(0); } while (0)
#define PG8_WAIT_V(n) asm volatile("s_waitcnt vmcnt(" #n ")" ::: "memory")
#define PG8_WAIT_L(n) asm volatile("s_waitcnt lgkmcnt(" #n ")" ::: "memory")
#define PG8_BAR __builtin_amdgcn_s_barrier()
#define PG8_SCHED __builtin_amdgcn_sched_barrier(0)
    Unit cur, nxt; int ui = 0;
    if (!S.next(0, cur)) return;
    unsigned vc[2][2], vn[2][2];
    S.aoff(cur, Rr, Cc, vc);
    f32x4 acc[2][2][4][2];
#pragma unroll
    for (int a = 0; a < 2; ++a)
#pragma unroll
        for (int b = 0; b < 2; ++b)
#pragma unroll
            for (int m = 0; m < 4; ++m)
#pragma unroll
                for (int n = 0; n < 2; ++n) acc[a][b][m][n] = (f32x4){0.f, 0.f, 0.f, 0.f};
    bf16x8 At[4][2], B0[2][2], B1[2][2];
    PG8_STAGE(PG8_SB(0, 0), cur.B, vB[0]); PG8_STAGE(PG8_SB(0, 1), cur.B, vB[1]); PG8_STAGE(PG8_SA(0, 0), cur.A, vc[0]); PG8_STAGE(PG8_SA(0, 1), cur.A, vc[1]);
    if (wr == 1) PG8_BAR;
    PG8_WAIT_V(2); PG8_BAR;
    PG8_STAGE(PG8_SB(1, 0), cur.B + kstep, vB[0]); PG8_STAGE(PG8_SA(1, 0), cur.A + kstep, vc[0]); PG8_STAGE(PG8_SB(1, 1), cur.B + kstep, vB[1]);
    PG8_WAIT_V(6); PG8_BAR;
    for (;;) {
        const bool has_next = S.next(ui + 1, nxt);
        if (has_next) S.aoff(nxt, Rr, Cc, vn);
        else {
#pragma unroll
            for (int h = 0; h < 2; ++h)
#pragma unroll
                for (int i = 0; i < 2; ++i) vn[h][i] = vc[h][i];
        }
        const char* nA = has_next ? nxt.A : cur.A; const char* nB = has_next ? nxt.B : cur.B;
        for (int t = 0; t < nt; t += 2) {
            const bool last = (t == nt - 2);
            const char* a1 = cur.A + (size_t)(t + 1) * kstep;
            const char* a2 = last ? nA : cur.A + (size_t)(t + 2) * kstep; const char* b2 = last ? nB : cur.B + (size_t)(t + 2) * kstep;
            const char* a3 = a2 + kstep; const char* b3 = b2 + kstep;
            unsigned va0[2], va1[2];
#pragma unroll
            for (int i = 0; i < 2; ++i) { va0[i] = last ? vn[0][i] : vc[0][i]; va1[i] = last ? vn[1][i] : vc[1][i]; }
            PG8_LDB(B0, 0, 0); PG8_LDB(B1, 0, 1); PG8_SCHED; PG8_LDA(At, 0, 0); PG8_STAGE(PG8_SA(1, 1), a1, vc[1]);
            PG8_WAIT_V(8); PG8_WAIT_L(0); PG8_BAR; PG8_MMA(0, 0, At, B0); PG8_MMA(0, 1, At, B1); PG8_BAR; PG8_SCHED;
            PG8_LDA(At, 0, 1); PG8_STAGE(PG8_SB(0, 0), b2, vB[0]); PG8_STAGE(PG8_SB(0, 1), b2, vB[1]); PG8_STAGE(PG8_SA(0, 0), a2, va0);
            PG8_WAIT_V(8); PG8_WAIT_L(0); PG8_BAR; PG8_MMA(1, 0, At, B0); PG8_MMA(1, 1, At, B1); PG8_BAR; PG8_SCHED;
            PG8_LDB(B0, 1, 0); PG8_LDB(B1, 1, 1); PG8_SCHED; PG8_LDA(At, 1, 0); PG8_STAGE(PG8_SA(0, 1), a2, va1);
            PG8_WAIT_V(8); PG8_WAIT_L(0); PG8_BAR; PG8_MMA(0, 0, At, B0); PG8_MMA(0, 1, At, B1); PG8_BAR; PG8_SCHED;
            PG8_LDA(At, 1, 1); PG8_STAGE(PG8_SB(1, 0), b3, vB[0]); PG8_STAGE(PG8_SB(1, 1), b3, vB[1]); PG8_STAGE(PG8_SA(1, 0), a3, va0);
            PG8_WAIT_V(8); PG8_WAIT_L(0); PG8_BAR; PG8_MMA(1, 0, At, B0); PG8_MMA(1, 1, At, B1); PG8_BAR; PG8_SCHED;
        }
        if (wr == 0) PG8_BAR;
        const bool keep = E(acc, cur, wr, wc, fr, fq);
        if (!has_next) break;
        if (!keep) {
#pragma unroll
            for (int a = 0; a < 2; ++a)
#pragma unroll
                for (int b = 0; b < 2; ++b)
#pragma unroll
                    for (int m = 0; m < 4; ++m)
#pragma unroll
                        for (int n = 0; n < 2; ++n) acc[a][b][m][n] = (f32x4){0.f, 0.f, 0.f, 0.f};
        }
        cur = nxt; ++ui;
#pragma unroll
        for (int h = 0; h < 2; ++h)
#pragma unroll
            for (int i = 0; i < 2; ++i) vc[h][i] = vn[h][i];
        if (wr == 1) PG8_BAR;
    }
    PG8_WAIT_V(0);
    PG8_BAR;
#undef PG8_SA
#undef PG8_SB
#undef PG8_STAGE
#undef PG8_LDA
#undef PG8_LDB
#undef PG8_MMA
#undef PG8_WAIT_V
#undef PG8_WAIT_L
#undef PG8_BAR
#undef PG8_SCHED
}
}

struct Frame {
    LAS unsigned char* lds;
    volatile LAS unsigned* MISC;
    unsigned* ctl;
    int tid, lane, wave, vcu, G;
    const float* in[26]; float* out; unsigned char* ws;
};
#define WSP(T, off) ((T*)(F.ws + (off)))

DI int dstrow_std(int s) { return (s & ~255) + ((s >> 5) & 1) * 128 + ((s >> 6) & 3) * 32 + (s & 31); }
DI int dstrow_glu(int s) { const int bj = s >> 10, w = s & 1023; return (w >> 7) * 256 + bj * 128 + (w & 127); }

template <bool GLU>
DI void p0_transpose_item(const float* W, int K, int N, bf16* WT, LAS float* scr, int item, int lane) {
    const int nblk = N / 32, kb = item / nblk, nb = item % nblk, k0 = 64 * kb, n0 = 32 * nb;
#pragma unroll 8
    for (int i = 0; i < 32; ++i) { const int kk = 2 * i + (lane >> 5); scr[kk * 33 + (lane & 31)] = W[(size_t)(k0 + kk) * N + n0 + (lane & 31)]; }
    LDS_WAIT(); asm volatile("" ::: "memory");
    const int c = lane & 7; const int d0 = GLU ? dstrow_glu(n0) : dstrow_std(n0);
#pragma unroll
    for (int j = 0; j < 4; ++j) { const int n = (lane >> 3) + 8 * j; const LAS float* s = scr + (8 * c) * 33 + n;
        u32x4 o; o.x = pk2(s[0 * 33], s[1 * 33]); o.y = pk2(s[2 * 33], s[3 * 33]); o.z = pk2(s[4 * 33], s[5 * 33]); o.w = pk2(s[6 * 33], s[7 * 33]);
        *(GAS u32x4*)(WT + (size_t)(d0 + n) * K + k0 + 8 * c) = o; }
    LDS_WAIT(); asm volatile("" ::: "memory");
}
DI void rms_row_to_bf16(int lane, const float* xrow, const float* gain, bf16* orow) {
    const GAS f32x4* xr = (const GAS f32x4*)xrow + lane; const GAS f32x4* gr = (const GAS f32x4*)gain + lane;
    f32x4 v[4]; float s = 0.f;
#pragma unroll
    for (int j = 0; j < 4; ++j) { v[j] = xr[64 * j]; s += (v[j].x * v[j].x + v[j].y * v[j].y) + (v[j].z * v[j].z + v[j].w * v[j].w); }
    const float rs = rsqrtf(wave_sum(s) * (1.f / DM) + EPS);
    GAS u32x2* o8 = (GAS u32x2*)orow + lane;
#pragma unroll
    for (int j = 0; j < 4; ++j) { const f32x4 g = gr[64 * j]; u32x2 w; w.x = pk2(v[j].x * rs * g.x, v[j].y * rs * g.y); w.y = pk2(v[j].z * rs * g.z, v[j].w * rs * g.w); o8[64 * j] = w; }
}

DI void p0_prologue(Frame& F) {
    LAS float* scr = (LAS float*)(F.lds + RING_OFF + F.wave * 16384);
    const int gw = F.vcu * NWAVES + F.wave, NGW = F.G * NWAVES;
    constexpr int I_IN = (DM / 64) * (INW / 32), I_GLU = (SSMW / 64) * (SSMW / 32), I_AP = (AOW / 64) * (DM / 32), I_SP = (SSMW / 64) * (DM / 32), I_OUT = (DM / 64) * (DM / 32);
    constexpr int I_GU1 = (DM / 64) * (2 * DFF / 32), I_DN1 = (DFF / 64) * (DM / 32);
    constexpr int NITEMS = I_IN + I_GLU + I_AP + I_SP + I_OUT + NE * I_GU1 + NE * I_DN1;
    for (int it = gw; it < NITEMS; it += NGW) {
        int r = it;
        if (r < I_IN) { p0_transpose_item<false>(F.in[2], DM, INW, WSP(bf16, WS_WIN), scr, r, F.lane); continue; } r -= I_IN;
        if (r < I_GLU) { p0_transpose_item<false>(F.in[14], SSMW, SSMW, WSP(bf16, WS_WGLU), scr, r, F.lane); continue; } r -= I_GLU;
        if (r < I_AP) { p0_transpose_item<false>(F.in[16], AOW, DM, WSP(bf16, WS_WAP), scr, r, F.lane); continue; } r -= I_AP;
        if (r < I_SP) { p0_transpose_item<false>(F.in[17], SSMW, DM, WSP(bf16, WS_WSP), scr, r, F.lane); continue; } r -= I_SP;
        if (r < I_OUT) { p0_transpose_item<false>(F.in[18], DM, DM, WSP(bf16, WS_WOUT), scr, r, F.lane); continue; } r -= I_OUT;
        if (r < NE * I_GU1) { const int e = r / I_GU1, ri = r % I_GU1;
            p0_transpose_item<true>(F.in[22] + (size_t)e * DM * 2 * DFF, DM, 2 * DFF, WSP(bf16, WS_WGU) + (size_t)e * 2 * DFF * DM, scr, ri, F.lane); continue; } r -= NE * I_GU1;
        { const int e = r / I_DN1, ri = r % I_DN1;
            p0_transpose_item<false>(F.in[24] + (size_t)e * DFF * DM, DFF, DM, WSP(bf16, WS_WD) + (size_t)e * DM * DFF, scr, ri, F.lane); }
    }
    for (int m = gw; m < T; m += NGW) rms_row_to_bf16(F.lane, F.in[0] + (size_t)m * DM, F.in[1], WSP(bf16, WS_H) + (size_t)m * DM);
    { const int i = gw * 64 + F.lane;
      if (i < 3 * 8 * 132) {
        const int st = i % 132, h = (i / 132) % 8, g = i / (132 * 8); const int dil = (g == 0) ? 1 : (g == 1 ? 4 : 16);
        float val = 0.f;
        if (st <= 128) { const int dist = st * dil; int bucket;
            if (dist < 16) bucket = dist; else { int large = 16 + (int)(logf((float)dist / 16.f) / 4.852030263919617f * 16.f); bucket = large < 31 ? large : 31; }
            val = F.in[5][bucket * NH + g * 8 + h] * LOG2E; }
        WSP(float, WS_BIAS2)[i] = val; } }
}

struct EpiInProj {
    bf16 *Q, *Kb, *V, *A2, *GA, *GB; const float *q_gain, *k_gain;
    DI bool operator()(f32x4 (&acc)[2][2][4][2], const pg8::Unit& u, int wr, int wc, int fr, int fq) const {
        const int pn = u.pn, rowb = u.pm * 256 + wr * 64 + fr;
        if (pn < 18) {
            const int three = pn / 6, pl = pn % 6, g = pl >> 1, h = 4 * (pl & 1) + wc;
            bf16* dst = Q + (size_t)three * ((WS_K - WS_Q) / 2);
            f32x4 gn[2][2];
            if (three < 2) { const float* gp = (three == 0 ? q_gain : k_gain) + g * 64 + 8 * fq; const float sc = three == 0 ? 0.125f * LOG2E : 1.f;
#pragma unroll
                for (int bj = 0; bj < 2; ++bj)
#pragma unroll
                    for (int n = 0; n < 2; ++n) gn[bj][n] = *(const f32x4*)(gp + 32 * bj + 4 * n) * sc; }
#pragma unroll
            for (int ai = 0; ai < 2; ++ai)
#pragma unroll
                for (int m = 0; m < 4; ++m) {
                    const int r = rowb + ai * 128 + m * 16, b = r >> 13, s = r & (SEQ - 1);
                    bf16* base = dst + ((((size_t)b * NG + g) * HPG + h) * SEQ + s) * HD + 8 * fq;
                    if (three < 2) {
                        float ss = 0.f;
#pragma unroll
                        for (int bj = 0; bj < 2; ++bj)
#pragma unroll
                            for (int n = 0; n < 2; ++n) { const f32x4 x = acc[ai][bj][m][n]; ss += (x[0] * x[0] + x[1] * x[1]) + (x[2] * x[2] + x[3] * x[3]); }
                        ss += __shfl_xor(ss, 16); ss += __shfl_xor(ss, 32);
                        const float rs = rsqrtf(ss * (1.f / HD) + EPS);
#pragma unroll
                        for (int bj = 0; bj < 2; ++bj) { const f32x4 v0 = acc[ai][bj][m][0] * gn[bj][0] * rs, v1 = acc[ai][bj][m][1] * gn[bj][1] * rs;
                            u32x4 w; w.x = cvt_pk_bf16(v0[0], v0[1]); w.y = cvt_pk_bf16(v0[2], v0[3]); w.z = cvt_pk_bf16(v1[0], v1[1]); w.w = cvt_pk_bf16(v1[2], v1[3]);
                            *(u32x4*)(base + 32 * bj) = w; }
                    } else {
#pragma unroll
                        for (int bj = 0; bj < 2; ++bj) { const f32x4 v0 = acc[ai][bj][m][0], v1 = acc[ai][bj][m][1];
                            u32x4 w; w.x = cvt_pk_bf16(v0[0], v0[1]); w.y = cvt_pk_bf16(v0[2], v0[3]); w.z = cvt_pk_bf16(v1[0], v1[1]); w.w = cvt_pk_bf16(v1[2], v1[3]);
                            *(u32x4*)(base + 32 * bj) = w; }
                    }
                }
        } else if (pn < 20) {
#pragma unroll
            for (int ai = 0; ai < 2; ++ai)
#pragma unroll
                for (int m = 0; m < 4; ++m) {
                    const int r = rowb + ai * 128 + m * 16;
#pragma unroll
                    for (int bj = 0; bj < 2; ++bj) { const int g = 16 * (pn - 18) + 4 * wc + 2 * bj + (fq >> 1);
                        bf16* d = A2 + ((size_t)g * NCHUNK + (r >> 5)) * A2K + (r & 31) * 16 + 8 * (fq & 1);
                        const f32x4 v0 = acc[ai][bj][m][0], v1 = acc[ai][bj][m][1];
                        u32x4 w; w.x = cvt_pk_bf16(v0[0], v0[1]); w.y = cvt_pk_bf16(v0[2], v0[3]); w.z = cvt_pk_bf16(v1[0], v1[1]); w.w = cvt_pk_bf16(v1[2], v1[3]);
                        *(u32x4*)d = w; }
                }
        } else {
            bf16* dst = GA + (size_t)(pn >= 24 ? 1 : 0) * ((WS_GB - WS_GA) / 2); const int col0 = 256 * ((pn - 20) & 3) + 64 * wc + 8 * fq;
#pragma unroll
            for (int ai = 0; ai < 2; ++ai)
#pragma unroll
                for (int m = 0; m < 4; ++m) {
                    const int r = rowb + ai * 128 + m * 16;
#pragma unroll
                    for (int bj = 0; bj < 2; ++bj) { const f32x4 v0 = acc[ai][bj][m][0], v1 = acc[ai][bj][m][1];
                        u32x4 w; w.x = cvt_pk_bf16(sigmoidf_(v0[0]), sigmoidf_(v0[1])); w.y = cvt_pk_bf16(sigmoidf_(v0[2]), sigmoidf_(v0[3]));
                        w.z = cvt_pk_bf16(sigmoidf_(v1[0]), sigmoidf_(v1[1])); w.w = cvt_pk_bf16(sigmoidf_(v1[2]), sigmoidf_(v1[3]));
                        *(u32x4*)(dst + (size_t)r * DM + col0 + 32 * bj) = w; }
                }
        }
        return false;
    }
};


constexpr int MOE_TAB_OFF = LDSCTL_OFF + 1024;
DI void moe_table(Frame& F) {
    LAS int* tb = (LAS int*)(F.lds + MOE_TAB_OFF);
    if (F.tid < NE) tb[64 + F.tid] = __hip_atomic_load((int*)F.ctl + F.tid, RLX_AGENT);
    __syncthreads();
    if (F.tid == 0) { int acc = 0; for (int e = 0; e < NE; ++e) { tb[e] = acc; acc += (tb[64 + e] + 255) >> 8; } tb[NE] = acc; }
    __syncthreads();
}
struct MoeSched {
    const char* A; const char* B; const int* LIST; const LAS int* tb; int nN, G, c; bool gather;
    DI bool next(int i, pg8::Unit& u) const {
        const int nMt = tb[NE]; const long L = (long)i * G + c; if (L >= (long)nMt * nN) return false;
        int pm, pn; pg8::tile_of((int)L, nMt, nN, pm, pn);
        int e = 0;
        for (int k = 1; k < NE; ++k) e = (tb[k] <= pm) ? k : e;
        u.pm = pm; u.pn = pn; u.e = e; u.aux = pm - tb[e];
        u.A = gather ? A : A + (size_t)pm * 256 * DM * 2;
        u.B = B + ((size_t)e * nN + pn) * 256 * DM * 2;
        return true;
    }
    DI void aoff(const pg8::Unit& u, const int (&R)[2], const int (&C)[2], unsigned (&v)[2][2]) const {
        if (gather) {
            const int cnt = tb[64 + u.e];
#pragma unroll
            for (int h = 0; h < 2; ++h)
#pragma unroll
                for (int i = 0; i < 2; ++i) { const int row = u.aux * 256 + h * 128 + R[i]; const int tok = row < cnt ? (LIST[u.e * LISTCAP + row] >> 2) : 0;
                    v[h][i] = (unsigned)(tok * DM + C[i]) * 2u; }
        } else {
#pragma unroll
            for (int h = 0; h < 2; ++h)
#pragma unroll
                for (int i = 0; i < 2; ++i) v[h][i] = (unsigned)((h * 128 + R[i]) * DM + C[i]) * 2u;
        }
    }
};
struct EpiGU {
    bf16* ACT; const float* bgu;
    DI bool operator()(f32x4 (&acc)[2][2][4][2], const pg8::Unit& u, int wr, int wc, int fr, int fq) const {
        const int c0 = 128 * u.pn + 32 * wc + 8 * fq;
        const float* bp = bgu + (size_t)u.e * 2 * DFF + c0;
        f32x4 bg[2], bl[2];
#pragma unroll
        for (int n = 0; n < 2; ++n) { bg[n] = *(const f32x4*)(bp + 4 * n); bl[n] = *(const f32x4*)(bp + DFF + 4 * n); }
#pragma unroll
        for (int ai = 0; ai < 2; ++ai)
#pragma unroll
            for (int m = 0; m < 4; ++m) {
                const size_t row = (size_t)u.pm * 256 + ai * 128 + wr * 64 + m * 16 + fr;
                float o[8];
#pragma unroll
                for (int n = 0; n < 2; ++n)
#pragma unroll
                    for (int i = 0; i < 4; ++i) {
                        const float xg = fminf(acc[ai][0][m][n][i] + bg[n][i], 7.f);
                        const float xl = fminf(fmaxf(acc[ai][1][m][n][i] + bl[n][i], -7.f), 7.f);
                        o[4 * n + i] = xg * __builtin_amdgcn_rcpf(1.f + __expf(-1.702f * xg)) * (xl + 1.f);
                    }
                u32x4 w; w.x = cvt_pk_bf16(o[0], o[1]); w.y = cvt_pk_bf16(o[2], o[3]); w.z = cvt_pk_bf16(o[4], o[5]); w.w = cvt_pk_bf16(o[6], o[7]);
                *(u32x4*)(ACT + row * DFF + c0) = w;
            }
        return false;
    }
};
struct EpiDown {
    bf16* YP; const float* bd; const int* LIST; const float* GATE; const LAS int* tb;
    DI bool operator()(f32x4 (&acc)[2][2][4][2], const pg8::Unit& u, int wr, int wc, int fr, int fq) const {
        const int cnt = tb[64 + u.e];
        const int col0 = 256 * u.pn + 64 * wc + 8 * fq;
        f32x4 bv[2][2];
#pragma unroll
        for (int bj = 0; bj < 2; ++bj)
#pragma unroll
            for (int n = 0; n < 2; ++n) bv[bj][n] = *(const f32x4*)(bd + (size_t)u.e * DM + col0 + 32 * bj + 4 * n);
#pragma unroll
        for (int ai = 0; ai < 2; ++ai)
#pragma unroll
            for (int m = 0; m < 4; ++m) {
                const int row = u.aux * 256 + ai * 128 + wr * 64 + m * 16 + fr;
                if (row < cnt) {
                    const int pair = LIST[u.e * LISTCAP + row]; const float gt = GATE[pair];
#pragma unroll
                    for (int bj = 0; bj < 2; ++bj) { const f32x4 v0 = (acc[ai][bj][m][0] + bv[bj][0]) * gt, v1 = (acc[ai][bj][m][1] + bv[bj][1]) * gt;
                        u32x4 w; w.x = cvt_pk_bf16(v0[0], v0[1]); w.y = cvt_pk_bf16(v0[2], v0[3]); w.z = cvt_pk_bf16(v1[0], v1[1]); w.w = cvt_pk_bf16(v1[2], v1[3]);
                        *(u32x4*)(YP + (size_t)pair * DM + col0 + 32 * bj) = w; }
                }
            }
        return false;
    }
};
DI void p_final(Frame& F) {
    const bf16* YP = WSP(bf16, WS_YP);
    for (size_t it = (size_t)blockIdx.x * NTHREADS + F.tid; it < (size_t)T * DM / 8; it += (size_t)F.G * NTHREADS) {
        const size_t t = it >> 7, c = (it & 127) * 8;
        f32x4 a = *(const f32x4*)(F.out + t * DM + c), b = *(const f32x4*)(F.out + t * DM + c + 4);
#pragma unroll
        for (int k = 0; k < 4; ++k) { const u32x4 y = *(const u32x4*)(YP + (t * 4 + k) * DM + c);
            a[0] += __uint_as_float(y.x << 16); a[1] += __uint_as_float(y.x & 0xffff0000u); a[2] += __uint_as_float(y.y << 16); a[3] += __uint_as_float(y.y & 0xffff0000u);
            b[0] += __uint_as_float(y.z << 16); b[1] += __uint_as_float(y.z & 0xffff0000u); b[2] += __uint_as_float(y.w << 16); b[3] += __uint_as_float(y.w & 0xffff0000u); }
        *(f32x4*)(F.out + t * DM + c) = a; *(f32x4*)(F.out + t * DM + c + 4) = b;
    }
}


DI f32x4 bf4lo(u32x2 p) { return (f32x4){__uint_as_float(p.x << 16), __uint_as_float(p.x & 0xffff0000u), __uint_as_float(p.y << 16), __uint_as_float(p.y & 0xffff0000u)}; }
struct EpiGlu {
    const bf16* YS; bf16* YS2; const float* b_glu;
    DI bool operator()(f32x4 (&acc)[2][2][4][2], const pg8::Unit& u, int wr, int wc, int fr, int fq) const {
        const int col0 = 256 * u.pn + 64 * wc + 8 * fq;
#pragma unroll
        for (int bj = 0; bj < 2; ++bj) {
            const f32x4 b0 = *(const f32x4*)(b_glu + col0 + 32 * bj), b1 = *(const f32x4*)(b_glu + col0 + 32 * bj + 4);
#pragma unroll
            for (int ai = 0; ai < 2; ++ai)
#pragma unroll
                for (int m = 0; m < 4; ++m) {
                    const size_t off = (size_t)(u.pm * 256 + ai * 128 + wr * 64 + m * 16 + fr) * SSMW + col0 + 32 * bj;
                    const u32x4 y = *(const u32x4*)(YS + off);
                    const f32x4 y0 = bf4lo((u32x2){y.x, y.y}), y1 = bf4lo((u32x2){y.z, y.w});
                    const f32x4 z0 = acc[ai][bj][m][0] + b0, z1 = acc[ai][bj][m][1] + b1;
                    float o[8];
#pragma unroll
                    for (int i = 0; i < 4; ++i) { o[i] = y0[i] * sigmoidf_(z0[i]); o[4 + i] = y1[i] * sigmoidf_(z1[i]); }
                    u32x4 w; w.x = cvt_pk_bf16(o[0], o[1]); w.y = cvt_pk_bf16(o[2], o[3]); w.z = cvt_pk_bf16(o[4], o[5]); w.w = cvt_pk_bf16(o[6], o[7]);
                    *(u32x4*)(YS2 + off) = w;
                }
        }
        return false;
    }
};
struct DualSched {
    const char *A0, *B0, *A1, *B1; int K, nM, nN, G, c;
    DI bool next(int i, pg8::Unit& u) const {
        const long L = (long)(i >> 1) * G + c; if (L >= (long)nM * nN) return false;
        int pm, pn; pg8::tile_of((int)L, nM, nN, pm, pn);
        const int part = i & 1;
        u.pm = pm; u.pn = pn; u.e = 0; u.aux = part;
        u.A = (part ? A1 : A0) + (size_t)pm * 256 * K * 2; u.B = (part ? B1 : B0) + (size_t)pn * 256 * K * 2; return true;
    }
    DI void aoff(const pg8::Unit&, const int (&R)[2], const int (&C)[2], unsigned (&v)[2][2]) const {
#pragma unroll
        for (int h = 0; h < 2; ++h)
#pragma unroll
            for (int i = 0; i < 2; ++i) v[h][i] = (unsigned)((h * 128 + R[i]) * K + C[i]) * 2u;
    }
};
struct EpiMix {
    const bf16 *GA, *GB; bf16* MIX;
    DI bool operator()(f32x4 (&acc)[2][2][4][2], const pg8::Unit& u, int wr, int wc, int fr, int fq) const {
        const int col0 = 256 * u.pn + 64 * wc + 8 * fq;
#pragma unroll
        for (int ai = 0; ai < 2; ++ai)
#pragma unroll
            for (int m = 0; m < 4; ++m)
#pragma unroll
                for (int bj = 0; bj < 2; ++bj) {
                    const size_t off = (size_t)(u.pm * 256 + ai * 128 + wr * 64 + m * 16 + fr) * DM + col0 + 32 * bj;
                    const u32x4 gb = *(const u32x4*)(GB + off);
                    const f32x4 gb0 = bf4lo((u32x2){gb.x, gb.y}), gb1 = bf4lo((u32x2){gb.z, gb.w});
                    if (u.aux == 0) {
                        const u32x4 ga = *(const u32x4*)(GA + off);
                        const f32x4 ga0 = bf4lo((u32x2){ga.x, ga.y}), ga1 = bf4lo((u32x2){ga.z, ga.w});
#pragma unroll
                        for (int i = 0; i < 4; ++i) { acc[ai][bj][m][0][i] *= ga0[i] * __builtin_amdgcn_rcpf(fmaxf(gb0[i], 1e-30f)); acc[ai][bj][m][1][i] *= ga1[i] * __builtin_amdgcn_rcpf(fmaxf(gb1[i], 1e-30f)); }
                    } else {
                        const f32x4 v0 = acc[ai][bj][m][0] * gb0, v1 = acc[ai][bj][m][1] * gb1;
                        u32x4 w; w.x = cvt_pk_bf16(v0[0], v0[1]); w.y = cvt_pk_bf16(v0[2], v0[3]); w.z = cvt_pk_bf16(v1[0], v1[1]); w.w = cvt_pk_bf16(v1[2], v1[3]);
                        *(u32x4*)(MIX + off) = w;
                    }
                }
        return u.aux == 0;
    }
};
struct EpiOut {
    const float* x; float* out;
    DI bool operator()(f32x4 (&acc)[2][2][4][2], const pg8::Unit& u, int wr, int wc, int fr, int fq) const {
        const int col0 = 256 * u.pn + 64 * wc + 8 * fq;
#pragma unroll
        for (int ai = 0; ai < 2; ++ai)
#pragma unroll
            for (int m = 0; m < 4; ++m)
#pragma unroll
                for (int bj = 0; bj < 2; ++bj) {
                    const size_t off = (size_t)(u.pm * 256 + ai * 128 + wr * 64 + m * 16 + fr) * DM + col0 + 32 * bj;
                    *(f32x4*)(out + off) = *(const f32x4*)(x + off) + acc[ai][bj][m][0];
                    *(f32x4*)(out + off + 4) = *(const f32x4*)(x + off + 4) + acc[ai][bj][m][1];
                }
        return false;
    }
};
constexpr int RT_OFF = LDSCTL_OFF + 2048;
DI void p_route(Frame& F) {
    LAS float* Wt = (LAS float*)(F.lds + RING_OFF);
    LAS int* rt = (LAS int*)(F.lds + RT_OFF);
    const float* wr_ = F.in[20];
    for (int idx = F.tid; idx < DM * NE; idx += NTHREADS) Wt[(idx & 31) * DM + (idx >> 5)] = wr_[idx];
    if (F.tid < 64) rt[F.tid] = 0;
    __syncthreads();
    const int rows_per_wg = T / F.G;
    const int row0 = F.vcu * rows_per_wg;
    const float* g_ffn = F.in[19]; const float* b_router = F.in[21];
    bf16* H2 = WSP(bf16, WS_H2); float* GATE = WSP(float, WS_GATE);
    const int lane = F.lane;
    for (int rl = F.wave; rl < rows_per_wg; rl += NWAVES) {
        const int t = row0 + rl;
        const GAS f32x4* xr = (const GAS f32x4*)(F.out + (size_t)t * DM) + lane; const GAS f32x4* gr = (const GAS f32x4*)g_ffn + lane;
        f32x4 v[4]; float s = 0.f;
#pragma unroll
        for (int j = 0; j < 4; ++j) { v[j] = xr[64 * j]; s += (v[j].x * v[j].x + v[j].y * v[j].y) + (v[j].z * v[j].z + v[j].w * v[j].w); }
        const float rs = rsqrtf(wave_sum(s) * (1.f / DM) + EPS);
        GAS u32x2* o8 = (GAS u32x2*)(H2 + (size_t)t * DM) + lane;
#pragma unroll
        for (int j = 0; j < 4; ++j) { v[j] = v[j] * rs * gr[64 * j]; u32x2 w; w.x = pk2(v[j].x, v[j].y); w.y = pk2(v[j].z, v[j].w); o8[64 * j] = w; }
        float p[32];
#pragma unroll
        for (int e = 0; e < 32; ++e) { float a = 0.f;
#pragma unroll
            for (int j = 0; j < 4; ++j) { const f32x4 w = *(const LAS f32x4*)(Wt + e * DM + 256 * j + 4 * lane); a += (v[j].x * w.x + v[j].y * w.y) + (v[j].z * w.z + v[j].w * w.w); }
            p[e] = a; }
#define RT_STEP(N, MASK) _Pragma("unroll") for (int i = 0; i < N; ++i) { const bool up = (lane & MASK) != 0; const float send = up ? p[i] : p[i + N]; const float keep = up ? p[i + N] : p[i]; p[i] = keep + __shfl_xor(send, MASK); }
        RT_STEP(16, 32) RT_STEP(8, 16) RT_STEP(4, 8) RT_STEP(2, 4) RT_STEP(1, 2)
#undef RT_STEP
        float mine = p[0] + __shfl_xor(p[0], 1);
        const int me = lane >> 1;
        mine = (lane & 1) ? -INFINITY : mine + b_router[me];
        float tv[4]; int ti[4];
#pragma unroll
        for (int k = 0; k < 4; ++k) {
            float bv = mine; int bi = me;
#pragma unroll
            for (int o = 1; o < 64; o <<= 1) { const float ov = __shfl_xor(bv, o); const int oi = __shfl_xor(bi, o); if (ov > bv || (ov == bv && oi < bi)) { bv = ov; bi = oi; } }
            tv[k] = bv; ti[k] = bi; if (me == bi) mine = -INFINITY;
        }
        float ex[4], se = 0.f;
#pragma unroll
        for (int k = 0; k < 4; ++k) { ex[k] = __expf(tv[k] - tv[0]); se += ex[k]; }
        if (lane < 4) {
            const int e = lane == 0 ? ti[0] : (lane == 1 ? ti[1] : (lane == 2 ? ti[2] : ti[3]));
            const float g = (lane == 0 ? ex[0] : (lane == 1 ? ex[1] : (lane == 2 ? ex[2] : ex[3]))) / se;
            const int lp = __hip_atomic_fetch_add(&rt[e], 1, __ATOMIC_RELAXED, __HIP_MEMORY_SCOPE_WORKGROUP);
            rt[64 + rl * 4 + lane] = (e << 16) | lp;
            GATE[t * 4 + lane] = g;
        }
    }
    __syncthreads();
    if (F.tid < NE) rt[32 + F.tid] = (int)atomicAdd(F.ctl + F.tid, (unsigned)rt[F.tid]);
    __syncthreads();
    int* LIST = WSP(int, WS_LIST);
    for (int i = F.tid; i < rows_per_wg * 4; i += NTHREADS) { const int info = rt[64 + i], e = info >> 16, lp = info & 0xffff; LIST[e * LISTCAP + rt[32 + e] + lp] = (row0 + (i >> 2)) * 4 + (i & 3); }
}


DI void ssm_abar(const float* a_re, const float* a_im, const float* log_dt, int g, int n, float& ar, float& ai, float& fr, float& fi) {
    const float dt = expf(log_dt[g]);
    const float lr = a_re[g * NST + n], li = a_im[g * NST + n];
    const float er = expf(lr * dt), sn = sinf(li * dt), cs = cosf(li * dt);
    ar = er * cs; ai = er * sn;
    const float nr = ar - 1.f, ni = ai, den = lr * lr + li * li;
    fr = (nr * lr + ni * li) / den; fi = (ni * lr - nr * li) / den;
}
DI void p0_ssm_prep(Frame& F, int g) {
    LAS float* L = (LAS float*)(F.lds + RING_OFF);
    LAS float* pwr = L;
    LAS float* pwi = L + 2176;
    LAS float* Cr = L + 4352;
    LAS float* Ci = Cr + 1024;
    LAS float* Br = Ci + 1024;
    LAS float* Bi = Br + 1024;
    LAS float* Kt = Bi + 1024;
    LAS float* Dk = Kt + 8192;
    const int tid = F.tid, lane = F.lane;
    if (tid < NST) {
        const int n = tid; float ar, ai, fr, fi; ssm_abar(F.in[6], F.in[7], F.in[8], g, n, ar, ai, fr, fi);
        float pr = 1.f, pi = 0.f;
        for (int k = 0; k < 34; ++k) { pwr[n * 34 + k] = pr; pwi[n * 34 + k] = pi; const float t = pr * ar - pi * ai; pi = pr * ai + pi * ar; pr = t; }
        for (int c = 0; c < 16; ++c) { const float br = F.in[9][(g * NST + n) * 16 + c], bi = F.in[10][(g * NST + n) * 16 + c];
            Br[n * 16 + c] = fr * br - fi * bi; Bi[n * 16 + c] = fr * bi + fi * br;
            Cr[c * 64 + n] = F.in[11][(g * 16 + c) * NST + n]; Ci[c * 64 + n] = F.in[12][(g * 16 + c) * NST + n]; }
    }
    if (tid >= 64 && tid < 80) Dk[tid - 64] = F.in[13][g * 16 + tid - 64];
    __syncthreads();
    for (int o = tid; o < 32 * 256; o += NTHREADS) {
        const int k = o >> 8, c = (o >> 4) & 15, cp = o & 15; float a = 0.f;
        for (int n = 0; n < NST; ++n) { const float pr = pwr[n * 34 + k], pi = pwi[n * 34 + k], cr = Cr[c * 64 + n], ci = Ci[c * 64 + n];
            a += (cr * pr - ci * pi) * Br[n * 16 + cp] - (cr * pi + ci * pr) * Bi[n * 16 + cp]; }
        Kt[o] = a;
    }
    __syncthreads();
    bf16* Bt2 = WSP(bf16, WS_BT2) + (size_t)g * 512 * A2K;
    for (int row = F.wave; row < 512; row += NWAVES) {
        const int s = row >> 4, c = row & 15; unsigned* dst = (unsigned*)(Bt2 + (size_t)dstrow_std(row) * A2K);
#pragma unroll
        for (int j = 0; j < 5; ++j) {
            const int col = 2 * lane + 128 * j; float v[2];
#pragma unroll
            for (int q = 0; q < 2; ++q) { const int cc = col + q; float x;
                if (cc < 512) { const int sp = cc >> 4, cp = cc & 15; x = sp <= s ? Kt[(s - sp) * 256 + c * 16 + cp] : 0.f; if (sp == s && cp == c) x += Dk[c]; }
                else { const int n = (cc - 512) & 63; const float pr = pwr[n * 34 + s + 1], pi = pwi[n * 34 + s + 1], cr = Cr[c * 64 + n], ci = Ci[c * 64 + n];
                    x = cc < 576 ? (cr * pr - ci * pi) : -(cr * pi + ci * pr); }
                v[q] = x; }
            dst[lane + 64 * j] = pk2(v[0], v[1]);
        }
    }
    bf16* Bt1 = WSP(bf16, WS_BT1) + (size_t)g * 128 * 512;
    for (int row = F.wave; row < 128; row += NWAVES) {
        const int n = row & 63; unsigned* dst = (unsigned*)(Bt1 + (size_t)row * 512);
#pragma unroll
        for (int j = 0; j < 4; ++j) {
            const int col = 2 * lane + 128 * j; float v[2];
#pragma unroll
            for (int q = 0; q < 2; ++q) { const int cc = col + q, sp = cc >> 4, cp = cc & 15; const float pr = pwr[n * 34 + 31 - sp], pi = pwi[n * 34 + 31 - sp], br = Br[n * 16 + cp], bi = Bi[n * 16 + cp];
                v[q] = row < 64 ? (pr * br - pi * bi) : (pr * bi + pi * br); }
            dst[lane + 64 * j] = pk2(v[0], v[1]);
        }
    }
    __syncthreads();
}
typedef float f32x16 __attribute__((ext_vector_type(16)));
DI void ssm_gemm1_task(Frame& F, int task) {
    const int g = task >> 6, mt = (task >> 2) & 15, ntile = task & 3, r32 = F.lane & 31, hi = F.lane >> 5;
    const bf16* Ap = WSP(bf16, WS_A2) + ((size_t)g * NCHUNK + 32 * mt + r32) * A2K + 8 * hi;
    const bf16* Bp = WSP(bf16, WS_BT1) + ((size_t)g * 128 + 32 * ntile + r32) * 512 + 8 * hi;
    f32x16 acc = {};
#pragma unroll 8
    for (int ks = 0; ks < 32; ++ks) {
        const bf16x8 a = *(const bf16x8*)(Ap + 16 * ks), b = *(const bf16x8*)(Bp + 16 * ks);
        acc = __builtin_amdgcn_mfma_f32_32x32x16_bf16(a, b, acc, 0, 0, 0);
    }
    float* S1 = WSP(float, WS_S1) + ((size_t)g * NCHUNK + 32 * mt) * 128 + 32 * ntile + r32;
#pragma unroll
    for (int r = 0; r < 16; ++r) S1[(size_t)((r & 3) + 8 * (r >> 2) + 4 * hi) * 128] = acc[r];
}
DI void ssm_scan_task(Frame& F, int task) {
    const int b = task >> 5, g = task & 31, n = F.tid & 63, seg = F.tid >> 6;
    LAS float* E = (LAS float*)(F.lds + RING_OFF);
    float ar, ai, fr, fi; ssm_abar(F.in[6], F.in[7], F.in[8], g, n, ar, ai, fr, fi);
    float Lr = ar, Li = ai;
#pragma unroll
    for (int k = 0; k < 5; ++k) { const float t = Lr * Lr - Li * Li; Li = 2.f * Lr * Li; Lr = t; }
    float Mr = Lr, Mi = Li;
#pragma unroll
    for (int k = 0; k < 5; ++k) { const float t = Mr * Mr - Mi * Mi; Mi = 2.f * Mr * Mi; Mr = t; }
    const int chunk0 = b * (NCHUNK / 2) + seg * 32;
    const float* S1 = WSP(float, WS_S1) + ((size_t)g * NCHUNK + chunk0) * 128 + n;
    float sr[32], si[32];
#pragma unroll
    for (int j = 0; j < 32; ++j) { sr[j] = S1[(size_t)j * 128]; si[j] = S1[(size_t)j * 128 + 64]; }
    float xr = 0.f, xi = 0.f;
#pragma unroll
    for (int j = 0; j < 32; ++j) { const float t = Lr * xr - Li * xi + sr[j]; xi = Lr * xi + Li * xr + si[j]; xr = t; }
    E[(seg * 64 + n) * 2] = xr; E[(seg * 64 + n) * 2 + 1] = xi;
    __syncthreads();
    xr = 0.f; xi = 0.f;
    for (int s2 = 0; s2 < seg; ++s2) { const float er = E[(s2 * 64 + n) * 2], ei = E[(s2 * 64 + n) * 2 + 1]; const float t = Mr * xr - Mi * xi + er; xi = Mr * xi + Mi * xr + ei; xr = t; }
    bf16* A2 = WSP(bf16, WS_A2) + ((size_t)g * NCHUNK + chunk0) * A2K + 512 + n;
#pragma unroll
    for (int j = 0; j < 32; ++j) { A2[(size_t)j * A2K] = f2bf(xr); A2[(size_t)j * A2K + 64] = f2bf(xi);
        const float t = Lr * xr - Li * xi + sr[j]; xi = Lr * xi + Li * xr + si[j]; xr = t; }
    __syncthreads();
}
DI void combine_items(Frame& F, int w0, int nw) {
    const bf16* OG = WSP(bf16, WS_OG); const float* LSE = WSP(float, WS_LSE); bf16* ATT = WSP(bf16, WS_ATT);
    for (size_t it = (size_t)(blockIdx.x - w0) * NTHREADS + F.tid; it < (size_t)T * AOW / 8; it += (size_t)nw * NTHREADS) {
        const size_t m = it >> 6; const int c = (int)(it & 63) * 8, h = c >> 6;
        float l[3], mx = -INFINITY;
#pragma unroll
        for (int g = 0; g < 3; ++g) { l[g] = LSE[((size_t)g * T + m) * 8 + h]; mx = fmaxf(mx, l[g]); }
        float w[3], sw = 0.f;
#pragma unroll
        for (int g = 0; g < 3; ++g) { w[g] = exp2f(l[g] - mx); sw += w[g]; }
        const float inv = 1.f / sw;
        f32x4 a0 = {0.f, 0.f, 0.f, 0.f}, a1 = {0.f, 0.f, 0.f, 0.f};
#pragma unroll
        for (int g = 0; g < 3; ++g) { const u32x4 y = *(const u32x4*)(OG + ((size_t)g * T + m) * AOW + c); const float wg = w[g] * inv;
            a0 += bf4lo((u32x2){y.x, y.y}) * wg; a1 += bf4lo((u32x2){y.z, y.w}) * wg; }
        u32x4 o; o.x = cvt_pk_bf16(a0[0], a0[1]); o.y = cvt_pk_bf16(a0[2], a0[3]); o.z = cvt_pk_bf16(a1[0], a1[1]); o.w = cvt_pk_bf16(a1[2], a1[3]);
        *(u32x4*)(ATT + m * AOW + c) = o;
    }
}
struct SsmSched {
    const char* A; const char* B; int G, c;
    DI bool next(int i, pg8::Unit& u) const {
        const int L = i * G + c; if (L >= 128) return false;
        const int g = L >> 2, pm = (L >> 1) & 1, pn = L & 1;
        u.pm = pm; u.pn = pn; u.e = g; u.aux = 0;
        u.A = A + ((size_t)g * 512 + pm * 256) * A2K * 2; u.B = B + ((size_t)g * 512 + pn * 256) * A2K * 2; return true;
    }
    DI void aoff(const pg8::Unit&, const int (&R)[2], const int (&C)[2], unsigned (&v)[2][2]) const {
#pragma unroll
        for (int h = 0; h < 2; ++h)
#pragma unroll
            for (int i = 0; i < 2; ++i) v[h][i] = (unsigned)((h * 128 + R[i]) * A2K + C[i]) * 2u;
    }
};
DI float gelu_fast(float x) { const float u = 1.5957691216057308f * (x + 0.044715f * x * x * x); return x * __builtin_amdgcn_rcpf(1.f + __expf(-u)); }
struct EpiSsm {
    bf16* YS;
    DI bool operator()(f32x4 (&acc)[2][2][4][2], const pg8::Unit& u, int wr, int wc, int fr, int fq) const {
#pragma unroll
        for (int ai = 0; ai < 2; ++ai)
#pragma unroll
            for (int m = 0; m < 4; ++m) {
                const int chunk = u.pm * 256 + ai * 128 + wr * 64 + m * 16 + fr;
#pragma unroll
                for (int bj = 0; bj < 2; ++bj) {
                    const int s = 16 * u.pn + 4 * wc + 2 * bj + (fq >> 1), c0 = 8 * (fq & 1);
                    const f32x4 v0 = acc[ai][bj][m][0], v1 = acc[ai][bj][m][1];
                    u32x4 w; w.x = cvt_pk_bf16(gelu_fast(v0[0]), gelu_fast(v0[1])); w.y = cvt_pk_bf16(gelu_fast(v0[2]), gelu_fast(v0[3]));
                    w.z = cvt_pk_bf16(gelu_fast(v1[0]), gelu_fast(v1[1])); w.w = cvt_pk_bf16(gelu_fast(v1[2]), gelu_fast(v1[3]));
                    *(u32x4*)(YS + (size_t)(chunk * 32 + s) * SSMW + u.e * 16 + c0) = w;
                }
            }
        return false;
    }
};


typedef short v4i16_t __attribute__((ext_vector_type(4)));
constexpr int AT_K = 0, AT_V = 49152, AT_BIAS = 98304;
DI int crow_(int r, int hi) { return (r & 3) + 8 * (r >> 2) + 4 * hi; }
DI void attn_unit(Frame& F, int uidx) {
    const int sub = uidx & 31, h = (uidx >> 5) & 7, g = (uidx >> 8) % 3, b = uidx / 768;
    const int dil = g == 0 ? 1 : (g == 1 ? 4 : 16);
    const int r = g == 0 ? 0 : (g == 1 ? (sub >> 3) : (sub >> 1)), qb = g == 0 ? sub : (g == 1 ? (sub & 7) : (sub & 1));
    const int lane = F.lane, w = F.wave, r32 = lane & 31, hi = lane >> 5;
    const size_t hb = ((((size_t)b * NG + g) * HPG + h) * SEQ) * HD;
    const bf16* Qh = WSP(bf16, WS_Q) + hb; const bf16* Kh = WSP(bf16, WS_K) + hb; const bf16* Vh = WSP(bf16, WS_V) + hb;
    const int j0 = 256 * qb - 128;
#pragma unroll
    for (int sidx = 0; sidx < 6; ++sidx) {
        { int j = j0 + 64 * sidx + lane; j = j < 0 ? 0 : j;
          __builtin_amdgcn_global_load_lds((const unsigned*)(Kh + (size_t)(r + dil * j) * HD + w * 8), (LAS unsigned*)(F.lds + AT_K + sidx * 8192 + w * 1024), 16, 0, 0); }
        { int j = j0 + 64 * sidx + 16 * (w & 3) + (lane >> 2); j = j < 0 ? 0 : j;
          __builtin_amdgcn_global_load_lds((const unsigned*)(Vh + (size_t)(r + dil * j) * HD + (w >> 2) * 32 + (lane & 3) * 8), (LAS unsigned*)(F.lds + AT_V + sidx * 8192 + w * 1024), 16, 0, 0); }
    }
    bf16x8 qr[4];
    { const bf16* qp = Qh + (size_t)(r + dil * (256 * qb + 32 * w + r32)) * HD + 8 * hi;
#pragma unroll
      for (int ks = 0; ks < 4; ++ks) qr[ks] = *(const bf16x8*)(qp + 16 * ks); }
    LAS float* biasL = (LAS float*)(F.lds + AT_BIAS);
    if (F.tid < 132) biasL[F.tid] = WSP(float, WS_BIAS2)[(g * 8 + h) * 132 + F.tid];
    asm volatile("s_waitcnt vmcnt(0)" ::: "memory");
    __syncthreads();
    f32x16 p[5];
    const LAS unsigned char* kb = F.lds + AT_K + hi * 1024 + r32 * 16;
#pragma unroll
    for (int kt = 0; kt < 5; ++kt) {
        const int tt = w + kt; const LAS unsigned char* kp = kb + (tt >> 1) * 8192 + (tt & 1) * 512;
        f32x16 a = {};
#pragma unroll
        for (int ks = 0; ks < 4; ++ks) a = __builtin_amdgcn_mfma_f32_32x32x16_bf16(*(const LAS bf16x8*)(kp + ks * 2048), qr[ks], a, 0, 0, 0);
        p[kt] = a;
    }
    const bool first = (qb == 0);
    float mx = -INFINITY;
#pragma unroll
    for (int kt = 0; kt < 5; ++kt) {
        const bool tile_ok = !first || (w + kt >= 4);
#pragma unroll
        for (int rg = 0; rg < 16; ++rg) {
            const int cr = crow_(rg, hi); int steps = 128 + r32 - 32 * kt - cr;
            bool ok = tile_ok;
            if (kt == 0) ok = ok && (cr >= r32);
            if (kt == 4) ok = ok && (cr <= r32);
            steps = steps < 0 ? 0 : (steps > 128 ? 128 : steps);
            const float v = ok ? p[kt][rg] + biasL[steps] : -INFINITY;
            p[kt][rg] = v; mx = fmaxf(mx, v);
        }
    }
    mx = fmaxf(mx, __shfl_xor(mx, 32));
    float l = 0.f;
#pragma unroll
    for (int kt = 0; kt < 5; ++kt)
#pragma unroll
        for (int rg = 0; rg < 16; ++rg) { const float e = __builtin_amdgcn_exp2f(p[kt][rg] - mx); p[kt][rg] = e; l += e; }
    l += __shfl_xor(l, 32);
    f32x16 o0 = {}, o1 = {};
    const LAS unsigned char* vb = F.lds + AT_V + ((lane >> 4) & 1) * 32 + (lane & 3) * 8 + (4 * hi + ((lane & 15) >> 2)) * 64;
#pragma unroll
    for (int kt = 0; kt < 5; ++kt) {
        const int tt = w + kt; const LAS unsigned char* vp = vb + (tt >> 1) * 8192 + (tt & 1) * 2048;
#pragma unroll
        for (int s2 = 0; s2 < 2; ++s2) {
            u32x4 pw; pw.x = cvt_pk_bf16(p[kt][8 * s2 + 0], p[kt][8 * s2 + 1]); pw.y = cvt_pk_bf16(p[kt][8 * s2 + 2], p[kt][8 * s2 + 3]);
            pw.z = cvt_pk_bf16(p[kt][8 * s2 + 4], p[kt][8 * s2 + 5]); pw.w = cvt_pk_bf16(p[kt][8 * s2 + 6], p[kt][8 * s2 + 7]);
            const bf16x8 pa = __builtin_bit_cast(bf16x8, pw);
#pragma unroll
            for (int d0 = 0; d0 < 2; ++d0) {
                const v4i16_t lo = __builtin_amdgcn_ds_read_tr16_b64_v4i16((LAS v4i16_t*)(vp + d0 * 4096 + s2 * 1024));
                const v4i16_t hv = __builtin_amdgcn_ds_read_tr16_b64_v4i16((LAS v4i16_t*)(vp + d0 * 4096 + s2 * 1024 + 512));
                const bf16x8 vf = (bf16x8){lo[0], lo[1], lo[2], lo[3], hv[0], hv[1], hv[2], hv[3]};
                if (d0 == 0) o0 = __builtin_amdgcn_mfma_f32_32x32x16_bf16(pa, vf, o0, 0, 0, 0);
                else o1 = __builtin_amdgcn_mfma_f32_32x32x16_bf16(pa, vf, o1, 0, 0, 0);
            }
        }
    }
    const float linv = __builtin_amdgcn_rcpf(l);
    bf16* OG = WSP(bf16, WS_OG) + (size_t)g * T * AOW + h * HD + r32;
    const int jq0 = 256 * qb + 32 * w;
#pragma unroll
    for (int rg = 0; rg < 16; ++rg) {
        const int cr = crow_(rg, hi); const float li = __shfl(linv, cr);
        const size_t m = (size_t)b * SEQ + r + dil * (jq0 + cr);
        OG[m * AOW] = f2bf(o0[rg] * li); OG[m * AOW + 32] = f2bf(o1[rg] * li);
    }
    if (hi == 0) { const size_t m = (size_t)b * SEQ + r + dil * (jq0 + r32); WSP(float, WS_LSE)[((size_t)g * T + m) * 8 + h] = mx + log2f(l); }
    __syncthreads();
}

struct Args { const float* in[26]; float* out; unsigned char* ws; int ph_lo, ph_hi, li, pad; };
constexpr int NPHASE = 12;
__global__ void __launch_bounds__(NTHREADS, 2) mega(Args args) {
    extern __shared__ __attribute__((aligned(16))) unsigned char lds[];
    Frame F;
    F.lds = (LAS unsigned char*)lds;
    F.MISC = (volatile LAS unsigned*)(F.lds + MISC_OFF);
    F.tid = threadIdx.x; F.lane = F.tid & 63; F.wave = __builtin_amdgcn_readfirstlane(F.tid >> 6);
    F.G = gridDim.x; { const int bx = blockIdx.x; F.vcu = (F.G % 8 == 0) ? (bx % 8) * (F.G / 8) + bx / 8 : bx; }
    F.ws = args.ws; F.out = args.out; F.ctl = (unsigned*)(args.ws + WS_CTL);
#pragma unroll
    for (int i = 0; i < 26; ++i) F.in[i] = args.in[i];
    for (int u = F.tid; u < (LDS_BYTES - LDSCTL_OFF) / 4; u += NTHREADS) ((LAS unsigned*)(F.lds + LDSCTL_OFF))[u] = 0u;
    __syncthreads();
    XcdBarrier bar = xcd_barrier_post(F.ctl + CW_BAR + args.li * XCD_BAR_WORDS, F.MISC + 8);
    const int lo = args.ph_lo, hi = args.ph_hi;
#define IN(k) (lo <= (k) && (k) < hi)
#define SEAM(k) do { if (IN(k) && IN((k) + 1)) xcd_barrier(bar); } while (0)

    if (IN(0)) { if (F.vcu < NSG) p0_ssm_prep(F, F.vcu); p0_prologue(F); SEAM(0); }
    if (IN(1)) {
        pg8::PlainSched S{(const char*)WSP(bf16, WS_H), (const char*)WSP(bf16, WS_WIN), DM, T / 256, INW / 256, F.G, (int)blockIdx.x};
        EpiInProj E{WSP(bf16, WS_Q), WSP(bf16, WS_K), WSP(bf16, WS_V), WSP(bf16, WS_A2), WSP(bf16, WS_GA), WSP(bf16, WS_GB), F.in[3], F.in[4]};
        pg8::gemm_phase(F.lds + RING_OFF, DM, S, E);
        SEAM(1);
    }
    if (IN(2)) {
        { const int per = (1536 + F.G - 1) / F.G; const int u1 = (F.vcu + 1) * per < 1536 ? (F.vcu + 1) * per : 1536;
          for (int u = F.vcu * per; u < u1; ++u) attn_unit(F, u); }
        for (int task = F.vcu * NWAVES + F.wave; task < 2048; task += F.G * NWAVES) ssm_gemm1_task(F, task);
        SEAM(2);
    }
    if (IN(3)) {
        if ((int)blockIdx.x < 64) ssm_scan_task(F, blockIdx.x); else combine_items(F, 64, F.G - 64);
        SEAM(3);
    }
    if (IN(4)) {
        SsmSched S{(const char*)WSP(bf16, WS_A2), (const char*)WSP(bf16, WS_BT2), F.G, (int)blockIdx.x};
        EpiSsm E{WSP(bf16, WS_YS)};
        pg8::gemm_phase(F.lds + RING_OFF, A2K, S, E);
        SEAM(4);
    }
    if (IN(5)) {
        pg8::PlainSched S{(const char*)WSP(bf16, WS_YS), (const char*)WSP(bf16, WS_WGLU), SSMW, T / 256, SSMW / 256, F.G, (int)blockIdx.x};
        EpiGlu E{WSP(bf16, WS_YS), WSP(bf16, WS_YS2), F.in[15]};
        pg8::gemm_phase(F.lds + RING_OFF, SSMW, S, E);
        SEAM(5);
    }
    if (IN(6)) {
        DualSched S{(const char*)WSP(bf16, WS_ATT), (const char*)WSP(bf16, WS_WAP), (const char*)WSP(bf16, WS_YS2), (const char*)WSP(bf16, WS_WSP), AOW, T / 256, DM / 256, F.G, (int)blockIdx.x};
        EpiMix E{WSP(bf16, WS_GA), WSP(bf16, WS_GB), WSP(bf16, WS_MIX)};
        pg8::gemm_phase(F.lds + RING_OFF, AOW, S, E);
        SEAM(6);
    }
    if (IN(7)) {
        pg8::PlainSched S{(const char*)WSP(bf16, WS_MIX), (const char*)WSP(bf16, WS_WOUT), DM, T / 256, DM / 256, F.G, (int)blockIdx.x};
        EpiOut E{F.in[0], F.out};
        pg8::gemm_phase(F.lds + RING_OFF, DM, S, E);
        SEAM(7);
    }
    if (IN(8)) { p_route(F); SEAM(8); }
    if (IN(9)) {
        moe_table(F);
        const LAS int* tb = (const LAS int*)(F.lds + MOE_TAB_OFF);
        MoeSched S{(const char*)WSP(bf16, WS_H2), (const char*)WSP(bf16, WS_WGU), WSP(int, WS_LIST), tb, 8, F.G, (int)blockIdx.x, true};
        EpiGU E{WSP(bf16, WS_ACT), F.in[23]};
        pg8::gemm_phase(F.lds + RING_OFF, DM, S, E);
        SEAM(9);
    }
    if (IN(10)) {
        moe_table(F);
        const LAS int* tb = (const LAS int*)(F.lds + MOE_TAB_OFF);
        MoeSched S{(const char*)WSP(bf16, WS_ACT), (const char*)WSP(bf16, WS_WD), WSP(int, WS_LIST), tb, 4, F.G, (int)blockIdx.x, false};
        EpiDown E{WSP(bf16, WS_YP), F.in[25], WSP(int, WS_LIST), WSP(float, WS_GATE), tb};
        pg8::gemm_phase(F.lds + RING_OFF, DFF, S, E);
        SEAM(10);
    }
    if (IN(11)) { p_final(F); }
#undef IN
#undef SEAM
}

static int g_grid = 0;
static bool mega_setup() {
    if (g_grid) return g_grid > 0;
    int dev = 0, cus = 0;
    if (hipGetDevice(&dev) != hipSuccess || hipDeviceGetAttribute(&cus, hipDeviceAttributeMultiprocessorCount, dev) != hipSuccess) { g_grid = -1; return false; }
    if (hipFuncSetAttribute((const void*)mega, hipFuncAttributeMaxDynamicSharedMemorySize, LDS_BYTES) != hipSuccess) { fprintf(stderr, "hipFuncSetAttribute failed\n"); g_grid = -1; return false; }
    g_grid = cus;
    if (g_grid != 256) fprintf(stderr, "note: %d CUs\n", g_grid);
    return true;
}
static void mega_launch(void* const* d_in, void* d_out, void* d_ws, int lo, int hi, int li, hipStream_t stream) {
    Args a{};
    for (int i = 0; i < 26; ++i) a.in[i] = (const float*)d_in[i];
    a.out = (float*)d_out; a.ws = (unsigned char*)d_ws; a.ph_lo = lo; a.ph_hi = hi; a.li = li; a.pad = 0;
    hipLaunchKernelGGL(mega, dim3(g_grid), dim3(NTHREADS), LDS_BYTES, stream, a);
}
static_assert(WS_V - WS_K == WS_K - WS_Q, "Q|K|V equally spaced");

extern "C" void kernel_launch(void* const* d_in, const int* in_sizes, int n_in, void* d_out, int out_size, void* d_ws, size_t ws_size, hipStream_t stream) {
    if (n_in != 26 || ws_size < WS_END) { fprintf(stderr, "kernel_launch: unexpected n_in %d / ws_size %zu\n", n_in, ws_size); return; }
    if (!mega_setup()) return;
    (void)hipMemsetAsync((char*)d_ws + WS_CTL, 0, 1 * MiB, stream);
    mega_launch(d_in, d_out, d_ws, 0, NPHASE, 0, stream);
}
```
